# Optimizing an MI355X kernel written in HIP

```python
import math
import jax
import jax.numpy as jnp
from jax import lax
import numpy as np

D_MODEL = 1024
BATCH = 16
SEQ = 256
DEPTH = 2
DEC_BATCH = 8
DEC_SEQ = 4096
PAST_LEN = 512

GRID_W = 64
N_BRANCH = 4
BRANCH_W = D_MODEL // N_BRANCH
HEAD_DIM = 64
CHUNK = 128
GM_GROUPS = BRANCH_W // HEAD_DIM
NA_HEADS = BRANCH_W // HEAD_DIM
NA_KH = 8
NA_KW = 16
SSM_H = 16
SSM_G = BRANCH_W // SSM_H
SSM_P = 64
GQA_HEADS = BRANCH_W // HEAD_DIM
GQA_KV = 2
GQA_REP = GQA_HEADS // GQA_KV
Q_BLOCK = 128
ROPE_BASE = 10000.0
EPS = 1e-6
NEG_INF = -1e30
PROJ_W = 11 * BRANCH_W + 2 * GQA_KV * HEAD_DIM + N_BRANCH * D_MODEL

kernel_name = 'hybrid_flow_prefix_trunk_step'


def _split_points():
    sizes = (BRANCH_W, BRANCH_W, BRANCH_W,
             BRANCH_W, BRANCH_W, BRANCH_W, BRANCH_W,
             BRANCH_W, BRANCH_W,
             BRANCH_W, GQA_KV * HEAD_DIM, GQA_KV * HEAD_DIM, BRANCH_W,
             N_BRANCH * D_MODEL)
    pts, acc = [], 0
    for s in sizes[:-1]:
        acc += s
        pts.append(acc)
    return pts


def rmsnorm(x, g):
    xf = x.astype(jnp.float32)
    y = xf * lax.rsqrt(jnp.mean(xf * xf, axis=-1, keepdims=True) + EPS)
    return y.astype(x.dtype) * g


def rope_2d(x):
    L = x.shape[1]
    t = jnp.arange(L)
    row = (t // GRID_W).astype(jnp.float32)
    col = (t % GRID_W).astype(jnp.float32)
    half = HEAD_DIM // 2
    nf = half // 2
    freqs = ROPE_BASE ** (-jnp.arange(nf, dtype=jnp.float32) / nf)

    def rot(xh, pos):
        ang = pos[:, None] * freqs[None, :]
        cos = jnp.cos(ang)[None, :, None, :]
        sin = jnp.sin(ang)[None, :, None, :]
        x1, x2 = xh[..., :nf], xh[..., nf:]
        return jnp.concatenate([x1 * cos - x2 * sin, x2 * cos + x1 * sin], axis=-1)

    out = jnp.concatenate([rot(x[..., :half], row), rot(x[..., half:], col)], axis=-1)
    return out.astype(x.dtype)


def block_attention(q, ks, vs):
    B, L, KVH, G, dh = q.shape
    nb = L // Q_BLOCK
    qb = q.reshape(B, nb, Q_BLOCK, KVH, G, dh).transpose(1, 0, 2, 3, 4, 5)
    lens = [k.shape[1] for k in ks]
    scale = HEAD_DIM ** -0.5

    def one(qi):
        s = jnp.concatenate([jnp.einsum('bqkgd,blkd->bkgql', qi, k).astype(jnp.float32) for k in ks], axis=-1)
        p = jax.nn.softmax(s * scale, axis=-1).astype(q.dtype)
        out, off = None, 0
        for k_len, v in zip(lens, vs):
            term = jnp.einsum('bkgql,blkd->bqkgd', p[..., off:off + k_len], v)
            out = term if out is None else out + term
            off += k_len
        return out

    o = lax.map(one, qb)
    return o.transpose(1, 0, 2, 3, 4, 5).reshape(B, L, KVH * G * dh)


def na_latent(q, k, v, k_ctx, v_ctx, rel_bias):
    B, L, H, dh = q.shape
    rows = L // GRID_W
    kh = min(NA_KH, rows)
    kw = NA_KW
    qg = q.reshape(B, rows, GRID_W, H, dh)
    kg = k.reshape(B, rows, GRID_W, H, dh)
    vg = v.reshape(B, rows, GRID_W, H, dh)
    r = jnp.arange(rows)
    start_r = jnp.clip(r - kh // 2, 0, rows - kh)
    row_idx = start_r[:, None] + jnp.arange(kh)[None, :]
    k_rows = kg[:, row_idx]
    v_rows = vg[:, row_idx].reshape(B, rows, kh * GRID_W, H, dh)
    cq = jnp.arange(GRID_W)
    start_c = jnp.clip(cq - kw // 2, 0, GRID_W - kw)
    in_win = (cq[None, :] >= start_c[:, None]) & (cq[None, :] < start_c[:, None] + kw)
    dr_idx = row_idx - r[:, None] + (NA_KH - 1)
    dc_idx = jnp.clip(cq[None, :] - cq[:, None], -(kw - 1), kw - 1) + (kw - 1)
    bias = rel_bias[:, dr_idx[:, None, :, None], dc_idx[None, :, None, :]]
    bias = jnp.transpose(bias, (1, 0, 2, 3, 4)).astype(jnp.float32)
    bias = jnp.where(in_win[None, None, :, None, :], bias, NEG_INF)
    scale = HEAD_DIM ** -0.5
    s_win = jnp.einsum('brqhd,brjkhd->brhqjk', qg, k_rows).astype(jnp.float32) * scale + bias[None]
    s_win = s_win.reshape(B, rows, H, GRID_W, kh * GRID_W)
    s_ctx = jnp.einsum('brqhd,bchd->brhqc', qg, k_ctx).astype(jnp.float32) * scale
    p = jax.nn.softmax(jnp.concatenate([s_win, s_ctx], axis=-1), axis=-1).astype(v.dtype)
    nw = kh * GRID_W
    o = jnp.einsum('brhqk,brkhd->brqhd', p[..., :nw], v_rows) + jnp.einsum('brhqc,bchd->brqhd', p[..., nw:], v_ctx)
    return o.reshape(B, L, H * dh)


def gmlp_mixer(u, v, g_v, ws, b):
    B, L, _ = u.shape
    vn = rmsnorm(v, g_v).reshape(B, L // CHUNK, CHUNK, GM_GROUPS, HEAD_DIM)
    sp = jnp.einsum('gqp,bnpgd->bnqgd', ws, vn) + b.T[None, None, :, :, None]
    return u * sp.reshape(B, L, BRANCH_W)


def _cmul(ar, ai, br, bi):
    return ar * br - ai * bi, ar * bi + ai * br


def _scan_op(e1, e2):
    a1r, a1i, b1r, b1i = e1
    a2r, a2i, b2r, b2i = e2
    ar, ai = _cmul(a2r, a2i, a1r, a1i)
    br, bi = _cmul(a2r, a2i, b1r, b1i)
    return ar, ai, br + b2r, bi + b2i


def s5_mixer(x, lp, s0):
    B, L, _ = x.shape
    u = x.astype(jnp.float32).reshape(B, L, SSM_G, SSM_H)
    ys, finals = [], []
    for d in range(2):
        reverse = d == 1
        dt = jnp.exp(lp['ssm_log_dt'][d].astype(jnp.float32))[:, None]
        a_re = lp['ssm_a_re'][d].astype(jnp.float32)
        a_im = lp['ssm_a_im'][d].astype(jnp.float32)
        mag = jnp.exp(dt * a_re)
        ab_re, ab_im = mag * jnp.cos(dt * a_im), mag * jnp.sin(dt * a_im)
        den = a_re * a_re + a_im * a_im
        nr, ni = ab_re - 1.0, ab_im
        coef_re = (nr * a_re + ni * a_im) / den
        coef_im = (ni * a_re - nr * a_im) / den
        bb_re, bb_im = _cmul(coef_re[..., None], coef_im[..., None],
                             lp['ssm_b_re'][d].astype(jnp.float32), lp['ssm_b_im'][d].astype(jnp.float32))
        bu_re = jnp.einsum('blgi,gpi->blgp', u, bb_re)
        bu_im = jnp.einsum('blgi,gpi->blgp', u, bb_im)
        shp = bu_re.shape
        _, _, s_re, s_im = lax.associative_scan(
            _scan_op, (jnp.broadcast_to(ab_re, shp), jnp.broadcast_to(ab_im, shp), bu_re, bu_im),
            reverse=reverse, axis=1)
        if s0 is None:
            idx = 0 if reverse else L - 1
            finals.append(jnp.stack([s_re[:, idx], s_im[:, idx]], axis=-1))
        else:
            t = jnp.arange(L, dtype=jnp.float32)
            n = (L - t) if reverse else (t + 1.0)
            pm = jnp.exp(n[:, None, None] * (dt * a_re)[None])
            ph = n[:, None, None] * (dt * a_im)[None]
            init = s0[:, d].astype(jnp.float32)
            add_re, add_im = _cmul((pm * jnp.cos(ph))[None], (pm * jnp.sin(ph))[None],
                                   init[:, None, ..., 0], init[:, None, ..., 1])
            s_re = s_re + add_re
            s_im = s_im + add_im
        ys.append(jnp.einsum('blgp,gip->blgi', s_re, lp['ssm_c_re'][d].astype(jnp.float32))
                  - jnp.einsum('blgp,gip->blgi', s_im, lp['ssm_c_im'][d].astype(jnp.float32)))
    y = (ys[0] + ys[1]).reshape(B, L, BRANCH_W) + lp['ssm_d'] * x.astype(jnp.float32)
    y = jax.nn.gelu(y)
    y = y * jax.nn.sigmoid(y @ lp['w_glu'] + lp['b_glu'])
    new_state = jnp.stack(finals, axis=1) if s0 is None else None
    return y.astype(x.dtype), new_state


def trunk_layer(x, cond, lp, cache):
    B, L, _ = x.shape
    mod = jax.nn.silu(cond) @ lp['w_ada'] + lp['b_ada']
    if mod.ndim == 2:
        mod = mod[:, None, :]
    shift, scale, gate = jnp.split(mod, 3, axis=-1)
    h = rmsnorm(x, lp['norm_g']) * (1.0 + scale) + shift
    (a_u, a_v, a_z, b_q, b_k, b_v, b_z, c_x, c_z, d_q, d_k, d_v, d_z, g_merge) = \
        jnp.split(h @ lp['w_in'], _split_points(), axis=-1)
    y_a = gmlp_mixer(a_u, a_v, lp['gm_v_g'], lp['gm_ws'], lp['gm_b']) * jax.nn.silu(a_z)
    q_na = b_q.reshape(B, L, NA_HEADS, HEAD_DIM)
    k_na = b_k.reshape(B, L, NA_HEADS, HEAD_DIM)
    v_na = b_v.reshape(B, L, NA_HEADS, HEAD_DIM)
    if cache is None:
        y_b = block_attention(q_na[:, :, :, None, :], [k_na], [v_na])
    else:
        y_b = na_latent(q_na, k_na, v_na, cache['na_k'], cache['na_v'], lp['na_rel_bias'])
    y_b = y_b * jax.nn.silu(b_z)
    y_c, s_fin = s5_mixer(c_x, lp, None if cache is None else cache['ssm'])
    y_c = y_c * jax.nn.silu(c_z)
    q_d = rmsnorm(d_q.reshape(B, L, GQA_HEADS, HEAD_DIM), lp['gqa_q_g'])
    k_d = rmsnorm(d_k.reshape(B, L, GQA_KV, HEAD_DIM), lp['gqa_k_g'])
    v_d = d_v.reshape(B, L, GQA_KV, HEAD_DIM)
    if cache is None:
        y_d = block_attention(q_d.reshape(B, L, GQA_KV, GQA_REP, HEAD_DIM), [k_d], [v_d])
    else:
        y_d = block_attention(rope_2d(q_d).reshape(B, L, GQA_KV, GQA_REP, HEAD_DIM),
                              [rope_2d(k_d), cache['gqa_k']], [v_d, cache['gqa_v']])
    y_d = y_d * jax.nn.silu(d_z)
    merged = None
    for n, y_n in enumerate((y_a, y_b, y_c, y_d)):
        term = jax.nn.sigmoid(g_merge[..., n * D_MODEL:(n + 1) * D_MODEL]) * (y_n @ lp['w_branch'][n])
        merged = term if merged is None else merged + term
    x = x + gate * (merged @ lp['w_out'])
    if cache is None:
        return x, (k_na, v_na, k_d, v_d, s_fin)
    return x, None


def setup_inputs(seed: int = 0) -> dict:
    key = jax.random.key(seed)
    ks = jax.random.split(key, 32)
    f32 = jnp.float32

    def nrm(k, shape, s):
        return jax.random.normal(k, shape, f32) * s

    a_im = math.pi * jnp.arange(SSM_P, dtype=f32)
    return {
        'x_prompt': nrm(ks[0], (BATCH, SEQ, D_MODEL), 1.0),
        'x_sample': nrm(ks[1], (DEC_BATCH, DEC_SEQ, D_MODEL), 1.0),
        'c': nrm(ks[2], (DEC_BATCH, D_MODEL), 1.0),
        'cache_na_k': nrm(ks[3], (DEC_BATCH, DEPTH, PAST_LEN, NA_HEADS, HEAD_DIM), 1.0),
        'cache_na_v': nrm(ks[4], (DEC_BATCH, DEPTH, PAST_LEN, NA_HEADS, HEAD_DIM), 1.0),
        'cache_gqa_k': nrm(ks[5], (DEC_BATCH, DEPTH, PAST_LEN, GQA_KV, HEAD_DIM), 1.0),
        'cache_gqa_v': nrm(ks[6], (DEC_BATCH, DEPTH, PAST_LEN, GQA_KV, HEAD_DIM), 1.0),
        'state_ssm': nrm(ks[7], (DEC_BATCH, DEPTH, 2, SSM_G, SSM_P, 2), 0.1),
        'c_ctx': nrm(ks[8], (D_MODEL,), 1.0),
        'norm_g': 1.0 + nrm(ks[9], (DEPTH, D_MODEL), 0.02),
        'w_ada': nrm(ks[10], (DEPTH, D_MODEL, 3 * D_MODEL), 0.5 * D_MODEL ** -0.5),
        'b_ada': nrm(ks[11], (DEPTH, 3 * D_MODEL), 0.01),
        'w_in': nrm(ks[12], (DEPTH, D_MODEL, PROJ_W), D_MODEL ** -0.5),
        'gm_v_g': 1.0 + nrm(ks[13], (DEPTH, BRANCH_W), 0.02),
        'gm_ws': nrm(ks[14], (DEPTH, GM_GROUPS, CHUNK, CHUNK), CHUNK ** -0.5),
        'gm_b': 1.0 + nrm(ks[15], (DEPTH, GM_GROUPS, CHUNK), 0.02),
        'na_rel_bias': nrm(ks[16], (DEPTH, NA_HEADS, 2 * NA_KH - 1, 2 * NA_KW - 1), 0.1),
        'ssm_a_re': -0.5 + nrm(ks[17], (DEPTH, 2, SSM_G, SSM_P), 0.01),
        'ssm_a_im': a_im + nrm(ks[18], (DEPTH, 2, SSM_G, SSM_P), 0.01),
        'ssm_log_dt': jax.random.uniform(ks[19], (DEPTH, 2, SSM_G), f32, math.log(0.001), math.log(0.1)),
        'ssm_b_re': nrm(ks[20], (DEPTH, 2, SSM_G, SSM_P, SSM_H), (2 * SSM_H) ** -0.5),
        'ssm_b_im': nrm(ks[21], (DEPTH, 2, SSM_G, SSM_P, SSM_H), (2 * SSM_H) ** -0.5),
        'ssm_c_re': nrm(ks[22], (DEPTH, 2, SSM_G, SSM_H, SSM_P), (2 * SSM_P) ** -0.5),
        'ssm_c_im': nrm(ks[23], (DEPTH, 2, SSM_G, SSM_H, SSM_P), (2 * SSM_P) ** -0.5),
        'ssm_d': nrm(ks[24], (DEPTH, BRANCH_W), 0.5),
        'w_glu': nrm(ks[25], (DEPTH, BRANCH_W, BRANCH_W), BRANCH_W ** -0.5),
        'b_glu': nrm(ks[26], (DEPTH, BRANCH_W), 0.01),
        'gqa_q_g': 1.0 + nrm(ks[27], (DEPTH, HEAD_DIM), 0.02),
        'gqa_k_g': 1.0 + nrm(ks[28], (DEPTH, HEAD_DIM), 0.02),
        'w_branch': nrm(ks[29], (DEPTH, N_BRANCH, BRANCH_W, D_MODEL), BRANCH_W ** -0.5),
        'w_out': nrm(ks[30], (DEPTH, D_MODEL, D_MODEL), D_MODEL ** -0.5),
        'final_g': 1.0 + nrm(ks[31], (D_MODEL,), 0.02),
    }


def reference(x_prompt, x_sample, c, cache_na_k, cache_na_v, cache_gqa_k, cache_gqa_v, state_ssm, c_ctx,
              norm_g, w_ada, b_ada, w_in, gm_v_g, gm_ws, gm_b, na_rel_bias, ssm_a_re, ssm_a_im, ssm_log_dt,
              ssm_b_re, ssm_b_im, ssm_c_re, ssm_c_im, ssm_d, w_glu, b_glu, gqa_q_g, gqa_k_g, w_branch, w_out,
              final_g):
    xp, xs = x_prompt, x_sample
    na_k_l, na_v_l, gqa_k_l, gqa_v_l, ssm_l = [], [], [], [], []
    for l in range(DEPTH):
        lp = dict(norm_g=norm_g[l], w_ada=w_ada[l], b_ada=b_ada[l], w_in=w_in[l], gm_v_g=gm_v_g[l],
                  gm_ws=gm_ws[l], gm_b=gm_b[l], na_rel_bias=na_rel_bias[l], ssm_a_re=ssm_a_re[l],
                  ssm_a_im=ssm_a_im[l], ssm_log_dt=ssm_log_dt[l], ssm_b_re=ssm_b_re[l], ssm_b_im=ssm_b_im[l],
                  ssm_c_re=ssm_c_re[l], ssm_c_im=ssm_c_im[l], ssm_d=ssm_d[l], w_glu=w_glu[l], b_glu=b_glu[l],
                  gqa_q_g=gqa_q_g[l], gqa_k_g=gqa_k_g[l], w_branch=w_branch[l], w_out=w_out[l])
        xp, (k_na, v_na, k_g, v_g, s_f) = trunk_layer(xp, c_ctx, lp, None)
        na_k_l.append(k_na)
        na_v_l.append(v_na)
        gqa_k_l.append(k_g)
        gqa_v_l.append(v_g)
        ssm_l.append(s_f)
        cache = dict(na_k=cache_na_k[:, l], na_v=cache_na_v[:, l], gqa_k=cache_gqa_k[:, l],
                     gqa_v=cache_gqa_v[:, l], ssm=state_ssm[:, l])
        xs, _ = trunk_layer(xs, c, lp, cache)
    y_prompt = rmsnorm(xp, final_g)
    y_sample = rmsnorm(xs, final_g)
    return (y_prompt, y_sample, jnp.stack(na_k_l, axis=1), jnp.stack(na_v_l, axis=1),
            jnp.stack(gqa_k_l, axis=1), jnp.stack(gqa_v_l, axis=1), jnp.stack(ssm_l, axis=1))
```

```cpp
#include <hip/hip_runtime.h>
#include <cstdio>
#include <cstdint>
namespace pg8 {
#define PG8_LAS __attribute__((address_space(3)))
typedef unsigned short bf16_t;
typedef short bf16x8 __attribute__((ext_vector_type(8)));
typedef float f32x4 __attribute__((ext_vector_type(4)));
typedef unsigned u32x4 __attribute__((ext_vector_type(4)));
constexpr int BM = 256, BK = 64, HALF = 128, HTB = HALF * BK * 2  , STAGE_BYTES = 8 * HTB, NXCD = 8, WGM = 8;

__host__ __device__ __forceinline__ int lds_byte(int r, int c) { const int st = (r >> 4) * 2 + (c >> 5), rr = r & 15, cc = c & 31, ob = rr * 64 + cc * 2; return st * 1024 + (ob ^ (((ob >> 9) & 1) << 5)); }
__host__ __device__ __forceinline__ void stage_rc(int b, int& R, int& C) { const int st = b / 1024, sb = b % 1024, swz = sb ^ (((sb >> 9) & 1) << 5); R = (st >> 1) * 16 + swz / 64; C = (st & 1) * 32 + (swz % 64) / 2; }
__host__ __device__ __forceinline__ int perm32(int rho) { const int n = rho >> 4, i = rho & 15; return 8 * (i >> 2) + 4 * n + (i & 3); }

struct Unit { int pm, pn; };
struct Gemm { const bf16_t* A; const bf16_t* Bt; int M, N, K, lda; };


struct StaticOrder {
    int nM, nN, nwg, G, c;
    __host__ __device__ void init(int M, int N, int G_, int c_, int bm = BM) { nM = M / bm; nN = N / BM; nwg = nM * nN; G = G_; c = c_; }
    __host__ __device__ bool next(int i, Unit& u) const {
        const long L = (long)i * G + c; if (L >= nwg) return false;
        int wgid = (int)L; { const int q = nwg / NXCD, r = nwg % NXCD, xcd = wgid % NXCD, off = wgid / NXCD; wgid = (xcd < r ? xcd * (q + 1) : r * (q + 1) + (xcd - r) * q) + off; }
        const int nig = WGM * nN, gid = wgid / nig, fm = gid * WGM, gsz = (nM - fm) < WGM ? (nM - fm) : WGM;
        u.pm = fm + ((wgid % nig) % gsz); u.pn = (wgid % nig) / gsz; return true;
    }
    __device__ __forceinline__ void a_ready(const Unit&) const {}
    __device__ __forceinline__ void done(const Unit&) const {}
};
__device__ __forceinline__ unsigned cvt_pk_bf16(float lo, float hi) { unsigned r; asm volatile("v_cvt_pk_bf16_f32 %0, %1, %2" : "=v"(r) : "v"(lo), "v"(hi)); return r; }

template <class Epi, class Sched, int MR = 4>
__device__ __forceinline__ void gemm_phase(PG8_LAS unsigned char* lds, const Gemm g, const Sched& S, const Epi& E, const int wave_s) {
    unsigned z_ = 0u; asm volatile("" : "+v"(z_)); int tid_ = (wave_s << 6) | (int)__builtin_amdgcn_mbcnt_hi(~0u, __builtin_amdgcn_mbcnt_lo(~0u, z_)); asm volatile("" : "+v"(tid_)); const int tid = tid_, wid = __builtin_amdgcn_readfirstlane(tid >> 6), lane = tid & 63, wr = wid >> 2, wc = wid & 3, fr = lane & 15, fq = lane >> 4;
    const int K = g.K, nt = K / BK;
    unsigned voffA[2], voffB[2];
#pragma unroll
    for (int i = 0; i < 2; ++i) { int R, C; stage_rc(tid * 16 + i * 8192, R, C); const int Rb = Epi::PERM ? ((R & ~31) + perm32(R & 31)) : R;
        voffA[i] = (unsigned)(R * g.lda + C) * 2u; voffB[i] = (unsigned)(Rb * K + C) * 2u; }
    const size_t kstep = (size_t)(BK * 2);
    const size_t hstep = (size_t)HALF * K * 2;
    const size_t tstep = 2 * hstep;
    const size_t hstepA = (size_t)(MR * 32) * g.lda * 2, tstepA = 2 * hstepA;
    const unsigned ldsw = (unsigned)wid * 1024u;
    const int aoff = lds_byte(wr * (MR * 16) + fr, fq * 8), boff = lds_byte(wc * 32 + fr, fq * 8);
#define PG8_SA(b, h) (((b) * 2 + (h)) * HTB)
#define PG8_SB(b, h) ((4 + (b) * 2 + (h)) * HTB)
#define PG8_STAGE(bufoff, gbase, voff) do { _Pragma("unroll") for (int _i = 0; _i < 2; ++_i) \
        __builtin_amdgcn_global_load_lds((const unsigned*)((const char*)(gbase) + (voff)[_i]), (PG8_LAS unsigned*)(lds + (bufoff) + ldsw + _i * 8192), 16, 0, 0); } while (0)
#define PG8_LDA(dst, b, h) do { _Pragma("unroll") for (int m = 0; m < MR; ++m) _Pragma("unroll") for (int k = 0; k < 2; ++k) dst[m][k] = *(const PG8_LAS bf16x8*)(lds + PG8_SA(b, h) + aoff + m * 2048 + k * 1024); } while (0)
#define PG8_LDB(dst, b, h) do { _Pragma("unroll") for (int n = 0; n < 2; ++n) _Pragma("unroll") for (int k = 0; k < 2; ++k) dst[n][k] = *(const PG8_LAS bf16x8*)(lds + PG8_SB(b, h) + boff + n * 2048 + k * 1024); } while (0)
#define PG8_MMA(ai, bj, At, Bt) do { __builtin_amdgcn_s_setprio(1); _Pragma("unroll") for (int m = 0; m < MR; ++m) _Pragma("unroll") for (int n = 0; n < 2; ++n) _Pragma("unroll") for (int k = 0; k < 2; ++k) \
        acc[ai][bj][m][n] = __builtin_amdgcn_mfma_f32_16x16x32_bf16(Bt[n][k], At[m][k], acc[ai][bj][m][n], 0, 0, 0); __builtin_amdgcn_s_setprio(0); } while (0)
#define PG8_WAIT_V(n) asm volatile("s_waitcnt vmcnt(" #n ")" ::: "memory")
#define PG8_WAIT_L(n) asm volatile("s_waitcnt lgkmcnt(" #n ")" ::: "memory")
#define PG8_BAR __builtin_amdgcn_s_barrier()
#define PG8_SCHED __builtin_amdgcn_sched_barrier(0)
    Unit cur, nxt; int ui = 0;
    if (!S.next(0, cur)) return;
    f32x4 acc[2][2][4][2];
#pragma unroll
    for (int a = 0; a < 2; ++a)
#pragma unroll
        for (int b = 0; b < 2; ++b)
#pragma unroll
            for (int m = 0; m < 4; ++m)
#pragma unroll
                for (int n = 0; n < 2; ++n) acc[a][b][m][n] = (f32x4){0.f, 0.f, 0.f, 0.f};
    bf16x8 At[4][2], B0[2][2], B1[2][2];
    const char* cA = (const char*)g.A + (size_t)cur.pm * tstepA; const char* cB = (const char*)g.Bt + (size_t)cur.pn * tstep;
    S.a_ready(cur);
    PG8_STAGE(PG8_SB(0, 0), cB, voffB); PG8_STAGE(PG8_SA(0, 0), cA, voffA); PG8_STAGE(PG8_SB(0, 1), cB + hstep, voffB); PG8_STAGE(PG8_SA(0, 1), cA + hstepA, voffA);
    if (wr == 1) PG8_BAR;
    PG8_WAIT_V(4); PG8_BAR;
    PG8_STAGE(PG8_SB(1, 0), cB + kstep, voffB); PG8_STAGE(PG8_SA(1, 0), cA + kstep, voffA); PG8_STAGE(PG8_SB(1, 1), cB + hstep + kstep, voffB);
    PG8_WAIT_V(6); PG8_BAR;
    for (;;) {
        const bool has_next = S.next(ui + 1, nxt);
        const char* nA = has_next ? (const char*)g.A + (size_t)nxt.pm * tstepA : cA; const char* nB = has_next ? (const char*)g.Bt + (size_t)nxt.pn * tstep : cB;
        for (int t = 0; t < nt; t += 2) {
            const bool last = (t == nt - 2);
            const char* a1 = cA + (size_t)(t + 1) * kstep;
            const char* a2 = last ? nA : cA + (size_t)(t + 2) * kstep; const char* b2 = last ? nB : cB + (size_t)(t + 2) * kstep;
            const char* a3 = a2 + kstep; const char* b3 = b2 + kstep;
            if (last && has_next) S.a_ready(nxt);
            PG8_LDB(B0, 0, 0); PG8_SCHED; PG8_LDA(At, 0, 0); PG8_STAGE(PG8_SA(1, 1), a1 + hstepA, voffA);
            PG8_WAIT_L(8); PG8_BAR; PG8_WAIT_L(0); PG8_MMA(0, 0, At, B0); PG8_BAR; PG8_SCHED;
            PG8_LDB(B1, 0, 1); PG8_STAGE(PG8_SB(0, 0), b2, voffB);
            PG8_BAR; PG8_WAIT_L(0); PG8_MMA(0, 1, At, B1); PG8_BAR;
            PG8_LDA(At, 0, 1); PG8_STAGE(PG8_SA(0, 0), a2, voffA);
            PG8_BAR; PG8_WAIT_L(0); PG8_MMA(1, 0, At, B0); PG8_BAR; PG8_SCHED;
            PG8_STAGE(PG8_SB(0, 1), b2 + hstep, voffB);
            PG8_WAIT_V(6); PG8_BAR; PG8_MMA(1, 1, At, B1); PG8_BAR;
            PG8_LDB(B0, 1, 0); PG8_SCHED; PG8_LDA(At, 1, 0); PG8_STAGE(PG8_SA(0, 1), a2 + hstepA, voffA);
            PG8_WAIT_L(8); PG8_BAR; PG8_WAIT_L(0); PG8_MMA(0, 0, At, B0); PG8_BAR; PG8_SCHED;
            PG8_LDB(B1, 1, 1); PG8_STAGE(PG8_SB(1, 0), b3, voffB);
            PG8_BAR; PG8_WAIT_L(0); PG8_MMA(0, 1, At, B1); PG8_BAR;
            PG8_LDA(At, 1, 1); PG8_STAGE(PG8_SA(1, 0), a3, voffA);
            PG8_BAR; PG8_WAIT_L(0); PG8_MMA(1, 0, At, B0); PG8_BAR; PG8_SCHED;
            PG8_STAGE(PG8_SB(1, 1), b3 + hstep, voffB);
            PG8_WAIT_V(6); PG8_BAR; PG8_MMA(1, 1, At, B1); PG8_BAR;
        }
        if constexpr (!Epi::AFTER_DRAIN) { unsigned z2_ = 0u; asm volatile("" : "+v"(z2_)); const int l2_ = (int)__builtin_amdgcn_mbcnt_hi(~0u, __builtin_amdgcn_mbcnt_lo(~0u, z2_));
            E(acc, cur, wr, wc, l2_ & 15, l2_ >> 4); S.done(cur); }
        if (!has_next) break;
#pragma unroll
        for (int a = 0; a < 2; ++a)
#pragma unroll
            for (int b = 0; b < 2; ++b)
#pragma unroll
                for (int m = 0; m < 4; ++m)
#pragma unroll
                    for (int n = 0; n < 2; ++n) acc[a][b][m][n] = (f32x4){0.f, 0.f, 0.f, 0.f};
        cur = nxt; cA = nA; cB = nB; ++ui;
    }
    PG8_WAIT_V(0);
    if (wr == 0) PG8_BAR;
    PG8_BAR;
    if constexpr (Epi::AFTER_DRAIN) { E.fused(acc, cur, wr, wc, fr, fq, lds, wid, lane); S.done(cur); }
#undef PG8_SA
#undef PG8_SB
#undef PG8_STAGE
#undef PG8_LDA
#undef PG8_LDB
#undef PG8_MMA
#undef PG8_WAIT_V
#undef PG8_WAIT_L
#undef PG8_BAR
#undef PG8_SCHED
}

}

constexpr int NWAVES = 8, NTHR = 512;
constexpr int D = 1024, TCTX = 4096, TLAT = 32768, T = TCTX + TLAT, NPROJ = 7168, PW = 2944;
constexpr int CTX_B = 16, CTX_L = 256, LAT_B = 8, LAT_L = 4096, PAST = 512, DEPTH = 2;
constexpr int C_AU = 0, C_AV = 256, C_AZ = 512, C_BQ = 768, C_BK = 1024, C_BV = 1280, C_BZ = 1536, C_CZ = 1792, C_DQ = 2048, C_DK = 2304, C_DV = 2432, C_DZ = 2560;
constexpr size_t O_Y = 0, O_NAK = 37748736, O_NAV = 39845888, O_GK = 41943040, O_GV = 42991616, O_SSM = 44040192, O_END = 44171264;
constexpr float EPS = 1e-6f;
constexpr size_t MiB = 1u << 20;
constexpr size_t WS_CTL = 0, CTL_ZERO_BYTES = 1 * MiB;
constexpr size_t WS_MOD = 1 * MiB;
constexpr size_t WS_ROPE = 1 * MiB + 256 * 1024;
constexpr size_t WS_KNC = 1 * MiB + 256 * 1024 + 16384;
constexpr size_t WS_GMWS = 1 * MiB + 512 * 1024;
constexpr size_t WS_WGLU = 1 * MiB + 768 * 1024;
constexpr size_t WS_WBR = 2 * MiB;
constexpr size_t WS_WOUT = 6 * MiB;
constexpr size_t WS_WIN = 10 * MiB;
constexpr size_t WS_S5T = 38 * MiB;
constexpr size_t WS_XN = 44 * MiB;
constexpr size_t WS_PROJ = 116 * MiB;
constexpr size_t WS_CX = 324 * MiB;
constexpr size_t WS_GSIG = 342 * MiB;
constexpr size_t WS_SIN = 486 * MiB;
constexpr size_t WS_NAC = 528 * MiB;
constexpr size_t WS_GQC = 576 * MiB;
constexpr size_t WS_END = 640 * MiB;
constexpr int CW_TMO = 0, CW_BAR = 4096;
constexpr int RING_BYTES = 131072, LDSCTL_OFF = 147456, MISC_OFF = LDSCTL_OFF + 320, LDS_BYTES = 151552;

#define GAS __attribute__((address_space(1)))
#define LAS __attribute__((address_space(3)))
typedef unsigned short bf16;
typedef unsigned v4u __attribute__((ext_vector_type(4)));
typedef unsigned v2u __attribute__((ext_vector_type(2)));
typedef float f32x4 __attribute__((ext_vector_type(4)));
typedef short bf16x8 __attribute__((ext_vector_type(8)));
typedef GAS unsigned gu32;
#define RLX_AGENT __ATOMIC_RELAXED, __HIP_MEMORY_SCOPE_AGENT
#define LDS_WAIT() asm volatile("s_waitcnt lgkmcnt(0)" ::: "memory")
#define VM_WAIT() asm volatile("s_waitcnt vmcnt(0)" ::: "memory")
__device__ __forceinline__ unsigned f2bf(float f) { unsigned u = __builtin_bit_cast(unsigned, f); return (u + 0x7fffu + ((u >> 16) & 1u)) >> 16; }
typedef __bf16 hwbf2 __attribute__((ext_vector_type(2)));
typedef float f32x2 __attribute__((ext_vector_type(2)));
__device__ __forceinline__ unsigned pk2(float lo, float hi) { const f32x2 v = {lo, hi}; return __builtin_bit_cast(unsigned, __builtin_convertvector(v, hwbf2)); }
__device__ __forceinline__ float bf2f(bf16 b) { return __builtin_bit_cast(float, (unsigned)b << 16); }
__device__ __forceinline__ float bflo(unsigned w) { return __builtin_bit_cast(float, w << 16); }
__device__ __forceinline__ float bfhi(unsigned w) { return __builtin_bit_cast(float, w & 0xffff0000u); }
template <int O> __device__ __forceinline__ float shx(float v) { return __builtin_bit_cast(float, __builtin_amdgcn_ds_swizzle(__builtin_bit_cast(int, v), (O << 10) | 0x1f)); }
__device__ __forceinline__ float half_sum(float v) { const unsigned b = __builtin_bit_cast(unsigned, v); auto rr = __builtin_amdgcn_permlane32_swap(b, b, false, false); return __builtin_bit_cast(float, (unsigned)rr[0]) + __builtin_bit_cast(float, (unsigned)rr[1]); }
__device__ __forceinline__ float half_max(float v) { const unsigned b = __builtin_bit_cast(unsigned, v); auto rr = __builtin_amdgcn_permlane32_swap(b, b, false, false); return fmaxf(__builtin_bit_cast(float, (unsigned)rr[0]), __builtin_bit_cast(float, (unsigned)rr[1])); }
__device__ __forceinline__ float wave_sum(float v) { v += shx<1>(v); v += shx<2>(v); v += shx<4>(v); v += shx<8>(v); v += shx<16>(v); return half_sum(v); }
__device__ __forceinline__ float wave_max(float v) { v = fmaxf(v, shx<1>(v)); v = fmaxf(v, shx<2>(v)); v = fmaxf(v, shx<4>(v)); v = fmaxf(v, shx<8>(v)); v = fmaxf(v, shx<16>(v)); return half_max(v); }
__device__ __forceinline__ float sigm(float x) { return __builtin_amdgcn_rcpf(1.f + __builtin_amdgcn_exp2f(-1.44269504088896f * x)); }
__device__ __forceinline__ float silu(float x) { return x * sigm(x); }
__device__ __forceinline__ float gelu_tanh(float x) { const float u = 0.7978845608028654f * (x + 0.044715f * x * x * x); return x * sigm(2.f * u); }

#define XB_TMO      128
#define XB_XCNT(j)  (256  + 64 * (j))
#define XB_XSUB(j)  (1280 + 64 * (j))
#define XB_XGEN(j)  (2304 + 64 * (j))
#define XB_TOP      3328
#define XB_TOPGEN   3392
#define XCD_BAR_WORDS 3456
#define XB_SPIN_CAP (1u << 18)

__device__ __forceinline__ unsigned xb_ld(unsigned* p)              { return __hip_atomic_load(p, __ATOMIC_RELAXED, __HIP_MEMORY_SCOPE_AGENT); }
__device__ __forceinline__ unsigned xb_add(unsigned* p, unsigned v) { return __hip_atomic_fetch_add(p, v, __ATOMIC_RELAXED, __HIP_MEMORY_SCOPE_AGENT); }
__device__ __forceinline__ unsigned xb_xcc_id() { return (unsigned)__builtin_amdgcn_s_getreg((3 << 11) | 20) & 0xFu; }
#define XB_SPIN(cond, bar) do { unsigned _sp = 0; while (cond) { __builtin_amdgcn_s_sleep(1); \
    if ((++_sp & 255u) == 0u) { if (xb_ld(&(bar)[XB_TMO])) break; if (_sp > XB_SPIN_CAP) { atomicAdd(&(bar)[XB_TMO], 1u); break; } } } } while (0)

struct XcdBarrier {
    unsigned* bar; unsigned x;
    volatile LAS unsigned* st;
};

__device__ __forceinline__ XcdBarrier xcd_barrier_post(unsigned* bar, volatile LAS unsigned* st) {
    XcdBarrier b; b.bar = bar; b.x = xb_xcc_id(); b.st = st;
    if (threadIdx.x == 0) (void)xb_add(&bar[XB_XCNT(b.x)], 1u);
    return b;
}
__device__ __forceinline__ void xcd_barrier_complete(unsigned* bar, unsigned x, unsigned& nloc, unsigned& nx) {
    const unsigned G = gridDim.x * gridDim.y * gridDim.z;
    unsigned sum, cnt, mine, sp = 0u;
    for (;;) {
        sum = 0u; cnt = 0u; mine = 0u;
#pragma unroll
        for (unsigned j = 0; j < 16; ++j) { const unsigned c = xb_ld(&bar[XB_XCNT(j)]); sum += c; cnt += (c > 0u) ? 1u : 0u; mine = (j == x) ? c : mine; }
        if (sum == G) break;
        __builtin_amdgcn_s_sleep(1);
        if ((++sp & 255u) == 0u) { if (xb_ld(&bar[XB_TMO])) break; if (sp > XB_SPIN_CAP) { atomicAdd(&bar[XB_TMO], 1u); break; } }
    }
    nloc = mine > 0u ? mine : 1u; nx = cnt > 0u ? cnt : 1u;
}

__device__ __forceinline__ void xcd_barrier(const XcdBarrier& b) {
    asm volatile("s_waitcnt vmcnt(0)" ::: "memory");
    __syncthreads();
    if (threadIdx.x == 0) {
        unsigned* bar = b.bar;
        __builtin_amdgcn_s_waitcnt(0);
        unsigned nloc = b.st[0], nx = b.st[1];
        if (nloc == 0u) { xcd_barrier_complete(bar, b.x, nloc, nx); b.st[0] = nloc; b.st[1] = nx; }
        const unsigned old = xb_add(&bar[XB_XSUB(b.x)], 1u);
        const unsigned gen = old / nloc;
        if (old + 1u == (gen + 1u) * nloc) {
            __builtin_amdgcn_fence(__ATOMIC_RELEASE, "agent");
            asm volatile("s_waitcnt vmcnt(0)" ::: "memory");
            const unsigned og = xb_add(&bar[XB_TOP], 1u);
            const unsigned tg = og / nx;
            if (og + 1u == (tg + 1u) * nx) xb_add(&bar[XB_TOPGEN], 1u);
            else XB_SPIN(xb_ld(&bar[XB_TOPGEN]) == tg, bar);
            __builtin_amdgcn_fence(__ATOMIC_ACQUIRE, "agent");
            xb_add(&bar[XB_XGEN(b.x)], 1u);
            asm volatile("s_waitcnt vmcnt(0)" ::: "memory");
        } else {
            XB_SPIN(xb_ld(&bar[XB_XGEN(b.x)]) == gen, bar);
            __builtin_amdgcn_fence(__ATOMIC_ACQUIRE, "agent");
            asm volatile("s_waitcnt vmcnt(0)" ::: "memory");
        }
    }
    __syncthreads();
}


struct Args { const float* in[32]; float* out; unsigned char* ws; int ph_lo, ph_hi, dup_code, dry_val; };
struct Frame {
    LAS unsigned char* lds;
    int tid, lane, wave, G, gw, NGW, dry, vcu, wave_s;
    const float* const* in; float* out; unsigned char* ws;
    __device__ __forceinline__ bf16* XN() const { return (bf16*)(ws + WS_XN); }
    __device__ __forceinline__ bf16* PROJ() const { return (bf16*)(ws + WS_PROJ); }
    __device__ __forceinline__ bf16* CX() const { return (bf16*)(ws + WS_CX); }
    __device__ __forceinline__ unsigned char* GSIG() const { return ws + WS_GSIG; }
    __device__ __forceinline__ float* MOD() const { return (float*)(ws + WS_MOD); }
    __device__ __forceinline__ float* ROPE() const { return (float*)(ws + WS_ROPE); }
};
enum { I_XP = 0, I_XS, I_C, I_CNAK, I_CNAV, I_CGK, I_CGV, I_SSM0, I_CCTX, I_NORMG, I_WADA, I_BADA, I_WIN, I_GMVG, I_GMWS, I_GMB, I_NABIAS, I_ARE, I_AIM, I_LOGDT,
       I_BRE, I_BIM, I_CRE, I_CIM, I_SSMD, I_WGLU, I_BGLU, I_GQG, I_GKG, I_WBR, I_WOUT, I_FING };
__device__ __forceinline__ const float* inp(const Frame& F, int i) { asm volatile("" : "+s"(i)); return F.in[i]; }
__device__ __forceinline__ int cond_of(int m) { return m < TCTX ? 0 : 1 + ((m - TCTX) >> 12); }
__device__ __forceinline__ const float* xrow(const Frame& F, int l, int m) {
    if (l == 0) return m < TCTX ? inp(F, I_XP) + (size_t)m * D : inp(F, I_XS) + (size_t)(m - TCTX) * D;
    return F.out + (size_t)m * D;
}

__device__ __forceinline__ void relocal(Frame& F) { unsigned z = 0u; asm volatile("" : "+v"(z)); int t = (F.wave_s << 6) | (int)__builtin_amdgcn_mbcnt_hi(~0u, __builtin_amdgcn_mbcnt_lo(~0u, z)); asm volatile("" : "+v"(t));       F.tid = t; F.lane = t & 63; F.wave = __builtin_amdgcn_readfirstlane(t >> 6); F.gw = blockIdx.x * NWAVES + F.wave; }
__device__ __forceinline__ void s5_build_tables(Frame& F, int it);
__device__ __forceinline__ void p0_transpose_item(const float* W, int K, int N, bf16* WT, LAS float* scr, int item, int lane, int nsc0 = 1 << 30, float sc = 1.f) {
    const int nblk = N / 32, kb = item / nblk, nb = item % nblk, k0 = 64 * kb, n0 = 32 * nb; const float wm_ = n0 >= nsc0 ? sc : 1.f;
#pragma unroll 8
    for (int i = 0; i < 32; ++i) { const int kk = 2 * i + (lane >> 5); scr[kk * 33 + (lane & 31)] = W[(size_t)(k0 + kk) * N + n0 + (lane & 31)] * wm_; }
    LDS_WAIT(); asm volatile("" ::: "memory");
    const int c = lane & 7;
#pragma unroll
    for (int j = 0; j < 4; ++j) { const int n = (lane >> 3) + 8 * j; const LAS float* s = scr + (8 * c) * 33 + n;
        v4u o; o.x = pk2(s[0 * 33], s[1 * 33]); o.y = pk2(s[2 * 33], s[3 * 33]); o.z = pk2(s[4 * 33], s[5 * 33]); o.w = pk2(s[6 * 33], s[7 * 33]);
        *(v4u*)(WT + (size_t)(n0 + n) * K + k0 + 8 * c) = o; }
    LDS_WAIT(); asm volatile("" ::: "memory");
}
__device__ __forceinline__ void ph_prologue(Frame& F) {
    relocal(F);
    for (int it = blockIdx.x; it < 128; it += F.G) s5_build_tables(F, it);
    LAS float* scr = (LAS float*)(F.lds + F.wave * 16384);
    constexpr int I_IN = (D / 64) * (NPROJ / 32), I_BR = (256 / 64) * (D / 32), I_OUT = (D / 64) * (D / 32), I_GLU = (256 / 64) * (256 / 32);
    constexpr int NIT = 2 * I_IN + 8 * I_BR + 2 * I_OUT + 2 * I_GLU;
    const bool s5wg = (int)blockIdx.x < 128; const int nsl_me = (F.G == 256) ? (s5wg ? 1 : 3) : 1, nsl_all = (F.G == 256) ? 4096 : F.NGW;
    const int sl0 = (F.G == 256) ? (s5wg ? F.gw : 1024 + (F.gw - 1024) * 3) : F.gw;
    for (int sj = 0; sj < nsl_me; ++sj)
    for (int it = sl0 + sj; it < NIT; it += nsl_all) {
        int r = it;
        if (r < 2 * I_IN) { const int l = r / I_IN; p0_transpose_item(inp(F, I_WIN) + (size_t)l * D * NPROJ, D, NPROJ, (bf16*)(F.ws + WS_WIN) + (size_t)l * NPROJ * D, scr, r % I_IN, F.lane, 3072, -1.44269504088896f); continue; } r -= 2 * I_IN;
        if (r < 8 * I_BR) { const int q = r / I_BR; p0_transpose_item(inp(F, I_WBR) + (size_t)q * 256 * D, 256, D, (bf16*)(F.ws + WS_WBR) + (size_t)q * D * 256, scr, r % I_BR, F.lane); continue; } r -= 8 * I_BR;
        if (r < 2 * I_OUT) { const int l = r / I_OUT; p0_transpose_item(inp(F, I_WOUT) + (size_t)l * D * D, D, D, (bf16*)(F.ws + WS_WOUT) + (size_t)l * D * D, scr, r % I_OUT, F.lane); continue; } r -= 2 * I_OUT;
        { const int l = r / I_GLU; p0_transpose_item(inp(F, I_WGLU) + (size_t)l * 65536, 256, 256, (bf16*)(F.ws + WS_WGLU) + (size_t)l * 65536, scr, r % I_GLU, F.lane); }
    }
    { const float* src = inp(F, I_GMWS); bf16* dst = (bf16*)(F.ws + WS_GMWS);
      for (int i = blockIdx.x * NTHR + F.tid; i < 2 * 4 * 128 * 128; i += F.G * NTHR) dst[i] = (bf16)f2bf(src[i]); }
    { float* rt = F.ROPE();
      for (int i = blockIdx.x * NTHR + F.tid; i < 64 * 16; i += F.G * NTHR) { const int pos = i >> 4, k = i & 15; const float fr = powf(10000.f, -(float)k / 16.f); const float a = (float)pos * fr;
          rt[2 * i] = cosf(a); rt[2 * i + 1] = sinf(a); } }
#pragma unroll
    for (int kvsel = 0; kvsel < 2; ++kvsel) { const float* cb = inp(F, kvsel ? I_CNAV : I_CNAK);
        for (int j = blockIdx.x * NTHR + F.tid; j < 262144; j += F.G * NTHR) { const int l = j >> 17, b = (j >> 14) & 7, rem = j & 16383;
            const float* src = cb + (size_t)(b * 2 + l) * (PAST * 256) + rem * 8;
            const f32x4 a = *(const f32x4*)src, c = *(const f32x4*)(src + 4); v4u o; o.x = pk2(a.x, a.y); o.y = pk2(a.z, a.w); o.z = pk2(c.x, c.y); o.w = pk2(c.z, c.w);
            *(v4u*)((bf16*)(F.ws + WS_NAC) + ((size_t)(l * 8 + b) * PAST + (rem >> 5)) * PW + kvsel * 256 + (rem & 31) * 8) = o; } }
    for (int it = F.G - 1 - (int)blockIdx.x; it < 32; it += F.G) { const int l = it >> 4, b = (it >> 1) & 7, kv = it & 1;
        const float* kp = inp(F, I_CGK) + (((size_t)(b * 2 + l) * PAST + F.tid) * 2 + kv) * 64; float q2 = 0.f;
#pragma unroll
        for (int d = 0; d < 64; d += 4) { const f32x4 v = *(const f32x4*)(kp + d); q2 += (v.x * v.x + v.y * v.y) + (v.z * v.z + v.w * v.w); }
        q2 = wave_max(q2);
        LAS float* red = (LAS float*)(F.lds + 130048);
        __syncthreads();
        if (F.lane == 0) red[F.wave] = q2;
        __syncthreads();
        if (F.tid == 0) { float m = red[0];
#pragma unroll
            for (int w = 1; w < 8; ++w) m = fmaxf(m, red[w]);
            ((float*)(F.ws + WS_KNC))[it] = m; }
    }
    __syncthreads();
    { LAS float* sc = (LAS float*)F.lds;
      LAS float* red = (LAS float*)(F.lds + 9 * 1024 * 4);
      bool loaded = false;
      for (int it = blockIdx.x; it < 2 * 48; it += F.G) {
          if (!loaded) { for (int i = F.tid; i < 9 * 1024; i += NTHR) { const int cd = i >> 10, k = i & 1023; const float v = cd == 0 ? inp(F, I_CCTX)[k] : inp(F, I_C)[(cd - 1) * 1024 + k]; sc[i] = silu(v); } loaded = true; __syncthreads(); }
          const int l = it / 48, o = (it % 48) * 64 + (F.tid & 63), kg = F.tid >> 6;
          const float* w = inp(F, I_WADA) + (size_t)l * D * 3072 + o;
          float acc[9];
#pragma unroll
          for (int c = 0; c < 9; ++c) acc[c] = 0.f;
          for (int k = kg * 128; k < kg * 128 + 128; ++k) { const float wv = w[(size_t)k * 3072];
#pragma unroll
              for (int c = 0; c < 9; ++c) acc[c] += sc[c * 1024 + k] * wv; }
#pragma unroll
          for (int c = 0; c < 9; ++c) red[(kg * 9 + c) * 64 + (F.tid & 63)] = acc[c];
          __syncthreads();
          for (int i = F.tid; i < 9 * 64; i += NTHR) { const int c = i >> 6, oo = i & 63; float s = 0.f;
#pragma unroll
              for (int g = 0; g < 8; ++g) s += red[(g * 9 + c) * 64 + oo];
              const int ocol = (it % 48) * 64 + oo; F.MOD()[(size_t)(l * 9 + c) * 3072 + ocol] = s + inp(F, I_BADA)[l * 3072 + ocol]; }
          __syncthreads();
      } }
}

__device__ __forceinline__ void ph_norm(Frame& F, int l) {
    relocal(F);
    const float* ng = inp(F, I_NORMG) + l * D;
    const int RPW = (T + F.NGW - 1) / F.NGW, mbeg = F.gw * RPW, mend = min(T, mbeg + RPW);
    int cd = -1;
    if (l > 0) {
        const bf16* x1 = (const bf16*)F.out;
        f32x4 am[2][2], sh[2][2];
        for (int m0 = mbeg; m0 < mend; m0 += 3) {
            v4u v[3][2];
#pragma unroll
            for (int u = 0; u < 3; ++u) { const int m = m0 + u; if (m < mend) {
#pragma unroll
                for (int j = 0; j < 2; ++j) v[u][j] = *(const v4u*)(x1 + (size_t)m * D + 512 * j + 8 * F.lane); } }
#pragma unroll
            for (int u = 0; u < 3; ++u) { const int m = m0 + u; if (m >= mend) continue;
                const int c_ = cond_of(m);
                if (c_ != cd) { cd = c_; const float* md = F.MOD() + (size_t)(l * 9 + cd) * 3072;
#pragma unroll
                    for (int j = 0; j < 2; ++j)
#pragma unroll
                        for (int q = 0; q < 2; ++q) { const int c = 512 * j + 8 * F.lane + 4 * q; am[j][q] = *(const f32x4*)(ng + c) * (*(const f32x4*)(md + 1024 + c) + 1.f); sh[j][q] = *(const f32x4*)(md + c); } }
                float s = 0.f; f32x4 x[2][2];
#pragma unroll
                for (int j = 0; j < 2; ++j) { const v4u q = v[u][j]; x[j][0] = (f32x4){bflo(q.x), bfhi(q.x), bflo(q.y), bfhi(q.y)}; x[j][1] = (f32x4){bflo(q.z), bfhi(q.z), bflo(q.w), bfhi(q.w)};
                    s += (x[j][0].x * x[j][0].x + x[j][0].y * x[j][0].y) + (x[j][0].z * x[j][0].z + x[j][0].w * x[j][0].w) + (x[j][1].x * x[j][1].x + x[j][1].y * x[j][1].y) + (x[j][1].z * x[j][1].z + x[j][1].w * x[j][1].w); }
                const float r = rsqrtf(wave_sum(s) * (1.f / D) + EPS);
                bf16* orow = F.XN() + (size_t)m * D;
#pragma unroll
                for (int j = 0; j < 2; ++j) { const f32x4 h0 = x[j][0] * r * am[j][0] + sh[j][0], h1 = x[j][1] * r * am[j][1] + sh[j][1];
                    v4u o; o.x = pk2(h0.x, h0.y); o.y = pk2(h0.z, h0.w); o.z = pk2(h1.x, h1.y); o.w = pk2(h1.z, h1.w); *(v4u*)(orow + 512 * j + 8 * F.lane) = o; } }
        }
        return;
    }
    f32x4 am[4], sh[4];
    for (int m0 = mbeg; m0 < mend; m0 += 3) {
        f32x4 v[3][4];
#pragma unroll
        for (int u = 0; u < 3; ++u) { const int m = m0 + u; if (m < mend) { const float* xr = xrow(F, l, m);
#pragma unroll
            for (int j = 0; j < 4; ++j) v[u][j] = *(const f32x4*)(xr + 256 * j + 4 * F.lane); } }
#pragma unroll
        for (int u = 0; u < 3; ++u) { const int m = m0 + u; if (m >= mend) continue;
            const int c_ = cond_of(m);
            if (c_ != cd) { cd = c_; const float* md = F.MOD() + (size_t)(l * 9 + cd) * 3072;
#pragma unroll
                for (int j = 0; j < 4; ++j) { const int c = 256 * j + 4 * F.lane; am[j] = *(const f32x4*)(ng + c) * (*(const f32x4*)(md + 1024 + c) + 1.f); sh[j] = *(const f32x4*)(md + c); } }
            float s = 0.f;
#pragma unroll
            for (int j = 0; j < 4; ++j) s += (v[u][j].x * v[u][j].x + v[u][j].y * v[u][j].y) + (v[u][j].z * v[u][j].z + v[u][j].w * v[u][j].w);
            const float r = rsqrtf(wave_sum(s) * (1.f / D) + EPS);
            bf16* orow = F.XN() + (size_t)m * D;
#pragma unroll
            for (int j = 0; j < 4; ++j) { const f32x4 h = v[u][j] * r * am[j] + sh[j]; v2u o; o.x = pk2(h.x, h.y); o.y = pk2(h.z, h.w); *(v2u*)(orow + 256 * j + 4 * F.lane) = o; } }
    }
}
__device__ __forceinline__ void ph_final(Frame& F) {
    relocal(F);
    const float* ng = inp(F, I_FING);
    f32x4 g4[2][2];
#pragma unroll
    for (int j = 0; j < 2; ++j) { g4[j][0] = *(const f32x4*)(ng + 512 * j + 8 * F.lane); g4[j][1] = *(const f32x4*)(ng + 512 * j + 8 * F.lane + 4); }
    const bf16* x2 = (const bf16*)(F.ws + WS_PROJ);
    for (int m0 = F.gw; m0 < T; m0 += 4 * F.NGW) {
        v4u v[4][2];
#pragma unroll
        for (int u = 0; u < 4; ++u) { const int m = m0 + u * F.NGW; if (m < T) {
#pragma unroll
            for (int j = 0; j < 2; ++j) v[u][j] = *(const v4u*)(x2 + (size_t)m * D + 512 * j + 8 * F.lane); } }
#pragma unroll
        for (int u = 0; u < 4; ++u) { const int m = m0 + u * F.NGW; if (m >= T) continue;
            float* yr = F.out + (size_t)m * D; float s = 0.f; f32x4 x[2][2];
#pragma unroll
            for (int j = 0; j < 2; ++j) { const v4u q = v[u][j]; x[j][0] = (f32x4){bflo(q.x), bfhi(q.x), bflo(q.y), bfhi(q.y)}; x[j][1] = (f32x4){bflo(q.z), bfhi(q.z), bflo(q.w), bfhi(q.w)};
                s += (x[j][0].x * x[j][0].x + x[j][0].y * x[j][0].y) + (x[j][0].z * x[j][0].z + x[j][0].w * x[j][0].w) + (x[j][1].x * x[j][1].x + x[j][1].y * x[j][1].y) + (x[j][1].z * x[j][1].z + x[j][1].w * x[j][1].w); }
            const float r = rsqrtf(wave_sum(s) * (1.f / D) + EPS);
#pragma unroll
            for (int j = 0; j < 2; ++j) { *(f32x4*)(yr + 512 * j + 8 * F.lane) = x[j][0] * r * g4[j][0]; *(f32x4*)(yr + 512 * j + 8 * F.lane + 4) = x[j][1] * r * g4[j][1]; } }
    }
}

struct EpiIn {
    static constexpr bool PERM = true, AFTER_DRAIN = false;
    bf16* proj; bf16* cx; unsigned char* gsig;
    __device__ __forceinline__ void operator()(const f32x4 (&acc)[2][2][4][2], const pg8::Unit& u, int wr, int wc, int fr, int fq) const {
        const int row0 = u.pm * 256 + wr * 64 + fr, cw = wc * 32 + 8 * fq;
        if (u.pn < 12) {
            const int pc0 = (u.pn < 7 ? u.pn : u.pn - 1) * 256;
            const float qs = (u.pn == 3) ? 0.125f * 1.44269504088896f : 1.f;
#pragma unroll
            for (int ai = 0; ai < 2; ++ai)
#pragma unroll
                for (int m = 0; m < 4; ++m) { const int row = row0 + ai * 128 + m * 16;
#pragma unroll
                    for (int bj = 0; bj < 2; ++bj) { const int c = cw + bj * 128; const f32x4 v0 = acc[ai][bj][m][0] * qs, v1 = acc[ai][bj][m][1] * qs;
                        v4u w; w.x = pg8::cvt_pk_bf16(v0[0], v0[1]); w.y = pg8::cvt_pk_bf16(v0[2], v0[3]); w.z = pg8::cvt_pk_bf16(v1[0], v1[1]); w.w = pg8::cvt_pk_bf16(v1[2], v1[3]);
                        bf16* dst = (u.pn == 7) ? cx + ((size_t)(c >> 4) * T + row) * 16 + (c & 8) : proj + (size_t)row * PW + pc0 + c;
                        *(v4u*)dst = w; } }
        } else {
            const int pg = u.pn - 12;
            unsigned char* gblk = gsig + ((size_t)((u.pm * 4 + (pg >> 2)) * 8 + (pg & 3) * 2)) * 32768 + ((wr * 2 + (wc >> 1)) * 4) * 1024 + (fq * 16 + fr) * 16 + (wc & 1) * 8;
#pragma unroll
            for (int ai = 0; ai < 2; ++ai)
#pragma unroll
                for (int m = 0; m < 4; ++m) { const int row = row0 + ai * 128 + m * 16;
#pragma unroll
                    for (int bj = 0; bj < 2; ++bj) { const int c = cw + bj * 128; const f32x4 v0 = acc[ai][bj][m][0], v1 = acc[ai][bj][m][1];
                        v2u w; w.x = 0u; w.y = 0u; const float k = 1.f / 255.f;
#pragma unroll
                        for (int j = 0; j < 4; ++j) { w.x = __builtin_amdgcn_cvt_pk_u8_f32(__builtin_amdgcn_rcpf(__builtin_fmaf(__builtin_amdgcn_exp2f(v0[j]), k, k)), j, w.x);
                            w.y = __builtin_amdgcn_cvt_pk_u8_f32(__builtin_amdgcn_rcpf(__builtin_fmaf(__builtin_amdgcn_exp2f(v1[j]), k, k)), j, w.y); }
                        *(v2u*)(gblk + (size_t)bj * 32768 + (ai * 16 + m) * 1024) = w; } }
        }
    }
};
struct EpiOut {
    static constexpr bool PERM = true, AFTER_DRAIN = false;
    const float* xp; const float* xs; bf16* x1; float* x2; const float* mod; int l;
    __device__ __forceinline__ void operator()(const f32x4 (&acc)[2][2][4][2], const pg8::Unit& u, int wr, int wc, int fr, int fq) const {
        const int row0 = u.pm * 256 + wr * 64 + fr, col0 = u.pn * 256 + wc * 32 + 8 * fq;
        const int cd = u.pm < 16 ? 0 : 1 + ((u.pm - 16) >> 4);
        const float* gate = mod + (size_t)cd * 3072 + 2048;
        f32x4 gv[2][2];
#pragma unroll
        for (int bj = 0; bj < 2; ++bj)
#pragma unroll
            for (int n = 0; n < 2; ++n) gv[bj][n] = *(const f32x4*)(gate + col0 + bj * 128 + n * 4);
        if (l == 0) {
            const float* xb = u.pm < 16 ? xp : xs - (size_t)TCTX * D;
#pragma unroll
            for (int ai = 0; ai < 2; ++ai)
#pragma unroll
                for (int mh = 0; mh < 2; ++mh) {
                    f32x4 xo[2][2][2];
#pragma unroll
                    for (int mm = 0; mm < 2; ++mm) { const size_t off = (size_t)(row0 + ai * 128 + (2 * mh + mm) * 16) * D + col0;
#pragma unroll
                        for (int bj = 0; bj < 2; ++bj)
#pragma unroll
                            for (int n = 0; n < 2; ++n) xo[mm][bj][n] = *(const f32x4*)(xb + off + bj * 128 + n * 4); }
#pragma unroll
                    for (int mm = 0; mm < 2; ++mm) { const size_t off = (size_t)(row0 + ai * 128 + (2 * mh + mm) * 16) * D + col0;
#pragma unroll
                        for (int bj = 0; bj < 2; ++bj) { const f32x4 r0 = xo[mm][bj][0] + gv[bj][0] * acc[ai][bj][2 * mh + mm][0], r1 = xo[mm][bj][1] + gv[bj][1] * acc[ai][bj][2 * mh + mm][1];
                            v4u w; w.x = pk2(r0.x, r0.y); w.y = pk2(r0.z, r0.w); w.z = pk2(r1.x, r1.y); w.w = pk2(r1.z, r1.w); *(v4u*)(x1 + off + bj * 128) = w; } }
                    asm volatile("" ::: "memory"); }
        } else {
#pragma unroll
            for (int ai = 0; ai < 2; ++ai) {
                v4u xo[4][2];
#pragma unroll
                for (int m = 0; m < 4; ++m) { const size_t off = (size_t)(row0 + ai * 128 + m * 16) * D + col0;
#pragma unroll
                    for (int bj = 0; bj < 2; ++bj) xo[m][bj] = *(const v4u*)(x1 + off + bj * 128); }
#pragma unroll
                for (int m = 0; m < 4; ++m) { const size_t off = (size_t)(row0 + ai * 128 + m * 16) * D + col0;
#pragma unroll
                    for (int bj = 0; bj < 2; ++bj) { const v4u q = xo[m][bj];
                        const f32x4 a0 = {bflo(q.x), bfhi(q.x), bflo(q.y), bfhi(q.y)}, a1 = {bflo(q.z), bfhi(q.z), bflo(q.w), bfhi(q.w)};
                        *(f32x4*)(x2 + off + bj * 128) = a0 + gv[bj][0] * acc[ai][bj][m][0]; *(f32x4*)(x2 + off + bj * 128 + 4) = a1 + gv[bj][1] * acc[ai][bj][m][1]; } }
                asm volatile("" ::: "memory"); }
        }
    }
};


template <int l>
struct EpiOut192 {
    static constexpr bool PERM = true, AFTER_DRAIN = false;
    const float* xp; const float* xs; bf16* x1; bf16* x2; const float* mod;
    __device__ __forceinline__ void operator()(const f32x4 (&acc)[2][2][4][2], const pg8::Unit& u, int wr, int wc, int fr, int fq) const {
        const int rb = u.pm * 192 + wr * 48, col0 = u.pn * 256 + wc * 32 + 8 * fq;
        const int cd0 = u.pm * 192 < TCTX ? 0 : 1 + ((u.pm * 192 - TCTX) >> 12), cd1 = u.pm * 192 + 191 < TCTX ? 0 : 1 + ((u.pm * 192 + 191 - TCTX) >> 12); const bool same = cd0 == cd1;
        f32x4 gu[2][2];
#pragma unroll
        for (int bj = 0; bj < 2; ++bj) { gu[bj][0] = *(const f32x4*)(mod + (size_t)cd0 * 3072 + 2048 + col0 + bj * 128); gu[bj][1] = *(const f32x4*)(mod + (size_t)cd0 * 3072 + 2048 + col0 + bj * 128 + 4); }
        f32x4 xo[l == 0 ? 2 : 1][3][2][2]; v4u xh[l == 0 ? 1 : 2][3][2];
#pragma unroll
        for (int ai = 0; ai < 2; ++ai)
#pragma unroll
            for (int m = 0; m < 3; ++m) { const int rblk = rb + ai * 96 + m * 16; const size_t off = (size_t)(rblk + fr) * D + col0;
                if (l == 0) { const float* xb = rblk < TCTX ? xp : xs - (size_t)TCTX * D;
#pragma unroll
                    for (int bj = 0; bj < 2; ++bj) { xo[l == 0 ? ai : 0][m][bj][0] = *(const f32x4*)(xb + off + bj * 128); xo[l == 0 ? ai : 0][m][bj][1] = *(const f32x4*)(xb + off + bj * 128 + 4); } }
                else {
#pragma unroll
                    for (int bj = 0; bj < 2; ++bj) xh[l == 0 ? 0 : ai][m][bj] = *(const v4u*)(x1 + off + bj * 128); } }
#pragma unroll
        for (int ai = 0; ai < 2; ++ai) {
#pragma unroll
            for (int m = 0; m < 3; ++m) { const int rblk = rb + ai * 96 + m * 16; const size_t off = (size_t)(rblk + fr) * D + col0;
                const float* gate = mod + (size_t)(rblk < TCTX ? 0 : 1 + ((rblk - TCTX) >> 12)) * 3072 + 2048;
#pragma unroll
                for (int bj = 0; bj < 2; ++bj) { f32x4 g0 = gu[bj][0], g1 = gu[bj][1];
                    if (!same) { g0 = *(const f32x4*)(gate + col0 + bj * 128); g1 = *(const f32x4*)(gate + col0 + bj * 128 + 4); }
                    if (l == 0) { const f32x4 r0 = xo[l == 0 ? ai : 0][m][bj][0] + g0 * acc[ai][bj][m][0], r1 = xo[l == 0 ? ai : 0][m][bj][1] + g1 * acc[ai][bj][m][1];
                        v4u w; w.x = pk2(r0.x, r0.y); w.y = pk2(r0.z, r0.w); w.z = pk2(r1.x, r1.y); w.w = pk2(r1.z, r1.w); *(v4u*)(x1 + off + bj * 128) = w; }
                    else { const v4u q = xh[l == 0 ? 0 : ai][m][bj]; const f32x4 a0 = {bflo(q.x), bfhi(q.x), bflo(q.y), bfhi(q.y)}, a1 = {bflo(q.z), bfhi(q.z), bflo(q.w), bfhi(q.w)};
                        const f32x4 r0 = a0 + g0 * acc[ai][bj][m][0], r1 = a1 + g1 * acc[ai][bj][m][1];
                        v4u w; w.x = pk2(r0.x, r0.y); w.y = pk2(r0.z, r0.w); w.z = pk2(r1.x, r1.y); w.w = pk2(r1.z, r1.w); *(v4u*)(x2 + off + bj * 128) = w; } } }
            asm volatile("" ::: "memory"); }
    }
};

__device__ __forceinline__ int ycol_of(int n) { return ((0x8730 >> (4 * n)) & 15) * 256; }
__device__ __forceinline__ int mg_off(int row, int chunk) { return row * 128 + ((chunk ^ ((row >> 1) & 7)) << 4); }
__device__ __forceinline__ void ph_merge(Frame& F, int l) {
    relocal(F);
    const int wm = F.wave >> 1, wn = F.wave & 1, fr = F.lane & 15, fq = F.lane >> 4;
    LAS unsigned char* lds = F.lds;
    constexpr int ABYTES = 256 * 128, BBYTES = 128 * 128, STG = ABYTES + BBYTES;
    const bf16* Yb = F.PROJ(); const bf16* WB = (const bf16*)(F.ws + WS_WBR) + (size_t)l * 4 * D * 256; const unsigned char* gs = F.GSIG(); bf16* outp = F.XN();
    const int lr = F.lane >> 3, lc = F.lane & 7;
    unsigned voffA[4], voffB[2];
#pragma unroll
    for (int i = 0; i < 4; ++i) { const int rr = (F.wave * 4 + i) * 8 + lr, gc = lc ^ ((rr >> 1) & 7); voffA[i] = (unsigned)(rr * PW + gc * 8) * 2u; }
#pragma unroll
    for (int i = 0; i < 2; ++i) { const int rr = (F.wave * 2 + i) * 8 + lr, gc = lc ^ ((rr >> 1) & 7), wrow = (rr & ~31) + pg8::perm32(rr & 31); voffB[i] = (unsigned)(wrow * 256 + gc * 8) * 2u; }
    constexpr int NU = 144 * 8;
    if (F.vcu >= NU) return;
    const int nu = (NU - 1 - F.vcu) / F.G + 1, ngs = nu * 16;
#define MG_STAGE(gsx, bufi) do { const int g_ = (gsx) < ngs ? (gsx) : ngs - 1; const int it_ = F.vcu + (g_ >> 4) * F.G, s_ = g_ & 15, n_ = s_ >> 2, k0_ = (s_ & 3) * 64; \
            LAS unsigned char* b_ = lds + (bufi) * STG; \
            const char* ya_ = (const char*)(Yb + (size_t)((it_ >> 3) * 256) * PW + ycol_of(n_) + k0_); const char* wb_ = (const char*)(WB + ((size_t)n_ * D + (it_ & 7) * 128) * 256 + k0_); \
            _Pragma("unroll") for (int i_ = 0; i_ < 4; ++i_) __builtin_amdgcn_global_load_lds((const unsigned*)(ya_ + voffA[i_]), (LAS unsigned*)(b_ + (F.wave * 4 + i_) * 1024), 16, 0, 0); \
            _Pragma("unroll") for (int i_ = 0; i_ < 2; ++i_) __builtin_amdgcn_global_load_lds((const unsigned*)(wb_ + voffB[i_]), (LAS unsigned*)(b_ + ABYTES + (F.wave * 2 + i_) * 1024), 16, 0, 0); } while (0)
#define MG_WAIT(N) do { asm volatile("" ::: "memory"); __builtin_amdgcn_s_waitcnt(((N) & 15) | (7 << 4) | (((N) >> 4) << 14)); __builtin_amdgcn_s_barrier(); asm volatile("" ::: "memory"); } while (0)
    MG_STAGE(0, 0); MG_STAGE(1, 1); MG_STAGE(2, 2);
    MG_WAIT(12);
    int bcur = 0;
    bf16x8 af0[4], af1[4], bfx[4];
#define MG_FRAG_A(AF, buf, kh) do { const LAS unsigned char* ab_ = lds + (buf) * STG; \
        _Pragma("unroll") for (int mi_ = 0; mi_ < 4; ++mi_) AF[mi_] = *(const LAS bf16x8*)(ab_ + mg_off(wm * 64 + mi_ * 16 + fr, (kh) * 4 + fq)); } while (0)
#define MG_FRAG_B(BF, buf, kh) do { const LAS unsigned char* bb_ = lds + (buf) * STG + ABYTES; \
        _Pragma("unroll") for (int ni_ = 0; ni_ < 4; ++ni_) BF[ni_] = *(const LAS bf16x8*)(bb_ + mg_off(wn * 64 + ni_ * 16 + fr, (kh) * 4 + fq)); } while (0)
#define MG_MMA(AF, BF) do { _Pragma("unroll") for (int mi_ = 0; mi_ < 4; ++mi_) _Pragma("unroll") for (int ni_ = 0; ni_ < 4; ++ni_) acc[mi_][ni_] = __builtin_amdgcn_mfma_f32_16x16x32_bf16(BF[ni_], AF[mi_], acc[mi_][ni_], 0, 0, 0); } while (0)
    MG_FRAG_A(af0, 0, 0);
    for (int u = 0; u < nu; ++u) {
        const int it = F.vcu + u * F.G, pm = it >> 3, pn = it & 7, r0 = pm * 256, c0 = pn * 128;
        f32x4 acc[4][4], tot[4][4];
#pragma unroll
        for (int i = 0; i < 4; ++i)
#pragma unroll
            for (int j = 0; j < 4; ++j) { acc[i][j] = (f32x4){0.f, 0.f, 0.f, 0.f}; tot[i][j] = (f32x4){0.f, 0.f, 0.f, 0.f}; }
        const unsigned char* gblk = gs + ((size_t)(pm * 4) * 8 + pn) * 32768 + (size_t)(F.wave * 4) * 1024 + F.lane * 16;
        for (int n = 0; n < 4; ++n) {
            v4u gq[4];
#pragma unroll
            for (int k4 = 0; k4 < 4; ++k4) { const int gsx = u * 16 + n * 4 + k4;
                MG_FRAG_B(bfx, bcur, 0); MG_FRAG_A(af1, bcur, 1);
                __builtin_amdgcn_sched_barrier(0);
                MG_MMA(af0, bfx);
                MG_FRAG_B(bfx, bcur, 1);
                __builtin_amdgcn_sched_barrier(0);
                if (k4 == 0) { if (u > 0 && n == 0) MG_WAIT(14); else MG_WAIT(6); }
                else if (k4 == 1) { if (u > 0 && n == 0) MG_WAIT(18); else MG_WAIT(10); }
                else if (k4 == 2) MG_WAIT(10);
                else MG_WAIT(6);
                MG_STAGE(gsx + 3, bcur);
                if (k4 == 0) {
#pragma unroll
                    for (int mi = 0; mi < 4; ++mi) gq[mi] = *(const v4u*)(gblk + (size_t)n * (8 * 32768) + mi * 1024); }
                bcur = bcur == 2 ? 0 : bcur + 1;
                MG_FRAG_A(af0, bcur, 0);
                __builtin_amdgcn_sched_barrier(0);
                MG_MMA(af1, bfx);
                __builtin_amdgcn_sched_barrier(0);
                if (k4 == 3) {
                    const float k255 = 1.f / 255.f;
#pragma unroll
                    for (int mi = 0; mi < 4; ++mi) {
#pragma unroll
                        for (int ni = 0; ni < 4; ++ni) { const unsigned q = gq[mi][ni];
                            f32x4 g; g.x = (float)(q & 255u) * k255; g.y = (float)((q >> 8) & 255u) * k255; g.z = (float)((q >> 16) & 255u) * k255; g.w = (float)(q >> 24) * k255;
                            tot[mi][ni] += g * acc[mi][ni]; acc[mi][ni] = (f32x4){0.f, 0.f, 0.f, 0.f}; } }
                }
            }
        }
#pragma unroll
        for (int mi = 0; mi < 4; ++mi)
#pragma unroll
            for (int p = 0; p < 2; ++p) { v4u o; o.x = pk2(tot[mi][2 * p].x, tot[mi][2 * p].y); o.y = pk2(tot[mi][2 * p].z, tot[mi][2 * p].w); o.z = pk2(tot[mi][2 * p + 1].x, tot[mi][2 * p + 1].y); o.w = pk2(tot[mi][2 * p + 1].z, tot[mi][2 * p + 1].w);
                *(v4u*)(outp + (size_t)(r0 + wm * 64 + mi * 16 + fr) * D + c0 + wn * 64 + 32 * p + 8 * fq) = o; }
    }
    MG_WAIT(0);
#undef MG_STAGE
#undef MG_WAIT
#undef MG_FRAG_A
#undef MG_FRAG_B
#undef MG_MMA
}


constexpr float AT_C = 0.125f * 1.44269504088896f;
__device__ __forceinline__ void ph_prep(Frame& F, int l) {
    relocal(F);
    const float* rope = F.ROPE();
    const int j = F.lane & 7, ug = F.lane >> 3;
    float gq8[8], gk8[8];
    { const f32x4* pq = (const f32x4*)(inp(F, I_GQG) + l * 64 + 8 * j); const f32x4* pk = (const f32x4*)(inp(F, I_GKG) + l * 64 + 8 * j); const f32x4 q0 = pq[0], q1 = pq[1], k0 = pk[0], k1 = pk[1];
      gq8[0] = q0.x; gq8[1] = q0.y; gq8[2] = q0.z; gq8[3] = q0.w; gq8[4] = q1.x; gq8[5] = q1.y; gq8[6] = q1.z; gq8[7] = q1.w; gk8[0] = k0.x; gk8[1] = k0.y; gk8[2] = k0.z; gk8[3] = k0.w; gk8[4] = k1.x; gk8[5] = k1.y; gk8[6] = k1.z; gk8[7] = k1.w; }
    const int hs = ug, col = hs < 4 ? C_DQ + hs * 64 : C_DK + (hs - 4) * 64;
    for (int m0 = F.gw; m0 < T; m0 += 6 * F.NGW) {
        v4u raw[6], kbv[6];
#pragma unroll
        for (int u = 0; u < 6; ++u) { const int m = m0 + u * F.NGW; raw[u] = (v4u){0u, 0u, 0u, 0u}; kbv[u] = raw[u];
            if (m < T) { const bf16* pr = F.PROJ() + (size_t)m * PW; raw[u] = *(const v4u*)(pr + col + 8 * j); if (m < TCTX) kbv[u] = *(const v4u*)(pr + (F.lane < 32 ? C_BK : C_BV) + 8 * (F.lane & 31)); } }
        f32x4 rqa[6][4];
#pragma unroll
        for (int u = 0; u < 6; ++u) { const int m = m0 + u * F.NGW;
#pragma unroll
            for (int i = 0; i < 4; ++i) rqa[u][i] = (f32x4){1.f, 0.f, 1.f, 0.f};
            if (m < T && m >= TCTX) { const int t = (m - TCTX) & 4095, pos = j < 4 ? (t >> 6) : (t & 63); const f32x4* rp = (const f32x4*)(rope + (pos * 16 + ((8 * j) & 15)) * 2);
#pragma unroll
                for (int i = 0; i < 4; ++i) rqa[u][i] = rp[i]; } }
#pragma unroll
        for (int u = 0; u < 6; ++u) { const int m = m0 + u * F.NGW; if (m >= T) continue;
            const bool lat = m >= TCTX; const int t = lat ? ((m - TCTX) & 4095) : (m & 255); const int grow = t >> 6, gcol = t & 63;
            bf16* pr = F.PROJ() + (size_t)m * PW;
            float x[8]; x[0] = bflo(raw[u].x); x[1] = bfhi(raw[u].x); x[2] = bflo(raw[u].y); x[3] = bfhi(raw[u].y); x[4] = bflo(raw[u].z); x[5] = bfhi(raw[u].z); x[6] = bflo(raw[u].w); x[7] = bfhi(raw[u].w);
            float ss = 0.f;
#pragma unroll
            for (int i = 0; i < 8; ++i) ss += x[i] * x[i];
            ss += shx<1>(ss); ss += shx<2>(ss); ss += shx<4>(ss);
            const float rn = rsqrtf(ss * (1.f / 64.f) + EPS) * (hs < 4 ? AT_C : 1.f);
            float y[8];
#pragma unroll
            for (int i = 0; i < 8; ++i) y[i] = x[i] * rn * (hs < 4 ? gq8[i] : gk8[i]);
            if (lat) {
                const f32x4 rq[4] = {rqa[u][0], rqa[u][1], rqa[u][2], rqa[u][3]};
#pragma unroll
                for (int i = 0; i < 8; ++i) { const float p = shx<2>(y[i]); const float cs = rq[i >> 1][(i & 1) * 2], sn = rq[i >> 1][(i & 1) * 2 + 1];
                    y[i] = (j & 2) ? y[i] * cs + p * sn : y[i] * cs - p * sn; }
            }
            if (hs < 6) { v4u o; o.x = pk2(y[0], y[1]); o.y = pk2(y[2], y[3]); o.z = pk2(y[4], y[5]); o.w = pk2(y[6], y[7]); if (!F.dry) *(v4u*)(pr + col + 8 * j) = o; }
            if (!lat && !F.dry) { const int b = m >> 8; const size_t r = (size_t)(b * 2 + l) * 256 + t;
                if (hs >= 4) { float* dst = F.out + (hs < 6 ? O_GK : O_GV) + r * 128 + (hs & 1) * 64 + 8 * j;
                    *(f32x4*)dst = hs < 6 ? (f32x4){y[0], y[1], y[2], y[3]} : (f32x4){x[0], x[1], x[2], x[3]}; *(f32x4*)(dst + 4) = hs < 6 ? (f32x4){y[4], y[5], y[6], y[7]} : (f32x4){x[4], x[5], x[6], x[7]}; }
                const v4u kb = kbv[u];
                float* dst = F.out + (F.lane < 32 ? O_NAK : O_NAV) + r * 256 + 8 * (F.lane & 31);
                *(f32x4*)dst = (f32x4){bflo(kb.x), bfhi(kb.x), bflo(kb.y), bfhi(kb.y)}; *(f32x4*)(dst + 4) = (f32x4){bflo(kb.z), bfhi(kb.z), bflo(kb.w), bfhi(kb.w)}; }
        }
    }
#pragma unroll
    for (int kvsel = 0; kvsel < 2; ++kvsel) { const float* cb = inp(F, kvsel ? I_CGV : I_CGK);
        for (int j = F.vcu * NTHR + F.tid; j < 65536; j += F.G * NTHR) { const int b = j >> 13, rem = j & 8191;
            const float* src = cb + (size_t)(b * 2 + l) * (PAST * 128) + rem * 8;
            const f32x4 a = *(const f32x4*)src, c = *(const f32x4*)(src + 4); v4u o; o.x = pk2(a.x, a.y); o.y = pk2(a.z, a.w); o.z = pk2(c.x, c.y); o.w = pk2(c.z, c.w);
            if (!F.dry) *(v4u*)((bf16*)(F.ws + WS_GQC) + ((size_t)b * PAST + (rem >> 4)) * PW + kvsel * 128 + (rem & 15) * 8) = o; } }
}

typedef float f32x16 __attribute__((ext_vector_type(16)));
typedef short s16x4 __attribute__((ext_vector_type(4)));
constexpr int AT_KSTR = 144, AT_VSTR = 144, AT_KBYTES = 64 * AT_KSTR, AT_STG = 18432, AT_BIAS_OFF = 2 * AT_STG;
struct AttnCfg {
    int q_m0, qcol, zcol;
    int nA, kA_m0, kcol, vcol;
    int nB, strideB; const float* kB; const float* vB;
    int na_r, na_R0, na_qc0;
    float sc;
};
template <bool NA, bool BOUND = false>
__device__ __forceinline__ void attn_item(Frame& F, const AttnCfg& c, const float kn2 = 0.f) {
    int tid_ = F.tid; asm volatile("" : "+v"(tid_));
    const int tid = tid_, lane = tid & 63, r = lane & 31, h = lane >> 5;
    LAS unsigned char* lds = F.lds; bf16* P = F.PROJ();
    bf16x8 qf[4];
    { const bf16* qp = P + (size_t)(c.q_m0 + r) * PW + c.qcol + 8 * h;
#pragma unroll
      for (int kk = 0; kk < 4; ++kk) qf[kk] = *(const bf16x8*)(qp + 16 * kk); }
    f32x16 o0, o1;
#pragma unroll
    for (int i = 0; i < 16; ++i) { o0[i] = 0.f; o1[i] = 0.f; }
    float mrow = -3.0e38f, lsum = 0.f;
    if (BOUND) { float q2 = 0.f;
#pragma unroll
        for (int kk = 0; kk < 4; ++kk) { const v4u w = __builtin_bit_cast(v4u, qf[kk]);
            q2 += bflo(w.x) * bflo(w.x) + bfhi(w.x) * bfhi(w.x) + bflo(w.y) * bflo(w.y) + bfhi(w.y) * bfhi(w.y) + bflo(w.z) * bflo(w.z) + bfhi(w.z) * bfhi(w.z) + bflo(w.w) * bflo(w.w) + bfhi(w.w) * bfhi(w.w); }
        q2 = half_sum(q2);
        mrow = sqrtf(q2 * kn2) * (c.sc * 1.02f); }
    const int ntiles = c.nA + c.nB, srow = tid >> 3, sch = tid & 7;
    v4u kA, vA; f32x4 kB0, kB1, vB0, vB1;
    kA = (v4u){0u, 0u, 0u, 0u}; vA = kA; kB0 = (f32x4){0.f, 0.f, 0.f, 0.f}; kB1 = kB0; vB0 = kB0; vB1 = kB0;
#define AT_LOAD(t) do { if ((t) < c.nA) { const bf16* p_ = P + (size_t)(c.kA_m0 + 64 * (t) + srow) * PW + sch * 8; kA = *(const v4u*)(p_ + c.kcol); vA = *(const v4u*)(p_ + c.vcol); } \
        else { const size_t o_ = (size_t)(64 * ((t) - c.nA) + srow) * c.strideB + sch * 8; kB0 = *(const f32x4*)(c.kB + o_); kB1 = *(const f32x4*)(c.kB + o_ + 4); vB0 = *(const f32x4*)(c.vB + o_); vB1 = *(const f32x4*)(c.vB + o_ + 4); } } while (0)
#define AT_WRITE(t) do { LAS unsigned char* b_ = lds + ((t) & 1) * AT_STG; v4u kk_, vv_; \
        if ((t) < c.nA) { kk_ = kA; vv_ = vA; } else { kk_.x = pk2(kB0.x, kB0.y); kk_.y = pk2(kB0.z, kB0.w); kk_.z = pk2(kB1.x, kB1.y); kk_.w = pk2(kB1.z, kB1.w); \
            vv_.x = pk2(vB0.x, vB0.y); vv_.y = pk2(vB0.z, vB0.w); vv_.z = pk2(vB1.x, vB1.y); vv_.w = pk2(vB1.z, vB1.w); } \
        *(LAS v4u*)(b_ + srow * AT_KSTR + sch * 16) = kk_; \
        *(LAS v4u*)(b_ + AT_KBYTES + srow * AT_VSTR + sch * 16) = vv_; } while (0)
    AT_LOAD(0);
    const int na_sr = NA ? min(max(c.na_r - 4, 0), 56) : 0;
    for (int t = 0; t < ntiles; ++t) {
        AT_WRITE(t);
        __syncthreads();
        if (t + 1 < ntiles) AT_LOAD(t + 1);
        bool active = true; int dr = 0;
        if (NA) { if (t < c.nA) { const int R = c.na_R0 + t; active = (R >= na_sr) && (R <= na_sr + 7); dr = R - c.na_r + 7; } }
        if (active) {
            const LAS unsigned char* Kt = lds + (t & 1) * AT_STG; const LAS unsigned char* Vt = Kt + AT_KBYTES;
            f32x16 s0, s1;
#pragma unroll
            for (int i = 0; i < 16; ++i) { s0[i] = 0.f; s1[i] = 0.f; }
#pragma unroll
            for (int kk = 0; kk < 4; ++kk) {
                const bf16x8 k0 = *(const LAS bf16x8*)(Kt + r * AT_KSTR + (16 * kk + 8 * h) * 2), k1 = *(const LAS bf16x8*)(Kt + (32 + r) * AT_KSTR + (16 * kk + 8 * h) * 2);
                s0 = __builtin_amdgcn_mfma_f32_32x32x16_bf16(k0, qf[kk], s0, 0, 0, 0); s1 = __builtin_amdgcn_mfma_f32_32x32x16_bf16(k1, qf[kk], s1, 0, 0, 0);
            }
            bf16x8 vf0[2][2], vf1[2][2];
#pragma unroll
            for (int sub = 0; sub < 2; ++sub)
#pragma unroll
                for (int st = 0; st < 2; ++st) {
                    const LAS unsigned char* vp = Vt + (32 * sub + 16 * st + 4 * h + ((lane & 15) >> 2)) * AT_VSTR + (16 * ((lane >> 4) & 1) + 4 * (lane & 3)) * 2;
                    const s16x4 a0 = __builtin_amdgcn_ds_read_tr16_b64_v4i16((LAS s16x4*)(vp)), a1 = __builtin_amdgcn_ds_read_tr16_b64_v4i16((LAS s16x4*)(vp + 8 * AT_VSTR));
                    const s16x4 c0 = __builtin_amdgcn_ds_read_tr16_b64_v4i16((LAS s16x4*)(vp + 64)), c1 = __builtin_amdgcn_ds_read_tr16_b64_v4i16((LAS s16x4*)(vp + 64 + 8 * AT_VSTR));
                    vf0[sub][st] = __builtin_shufflevector(a0, a1, 0, 1, 2, 3, 4, 5, 6, 7); vf1[sub][st] = __builtin_shufflevector(c0, c1, 0, 1, 2, 3, 4, 5, 6, 7); }
            __builtin_amdgcn_sched_barrier(0);
            if (NA && t < c.nA) {
                const int qc = c.na_qc0 + r, sc = min(max(qc - 8, 0), 48);
                const LAS float* bt = (const LAS float*)(lds + AT_BIAS_OFF) + dr * 31 + 15 - qc + 4 * h;
                const unsigned kb = (unsigned)(4 * h - sc);
#pragma unroll
                for (int i = 0; i < 16; ++i) { const int k0_ = (i & 3) + 8 * (i >> 2);
                    s0[i] = (kb + (unsigned)k0_ < 16u) ? __builtin_fmaf(s0[i], c.sc, bt[k0_]) : -1.0e30f;
                    s1[i] = (kb + (unsigned)(32 + k0_) < 16u) ? __builtin_fmaf(s1[i], c.sc, bt[32 + k0_]) : -1.0e30f; }
            }
            const float sc_ = (NA && t < c.nA) ? 1.f : c.sc;
            float mn = mrow;
            if (!BOUND) {
                float mxa = fmaxf(s0[0], s0[1]), mxb = fmaxf(s1[0], s1[1]);
#pragma unroll
                for (int i = 2; i < 16; i += 2) { mxa = fmaxf(mxa, fmaxf(s0[i], s0[i + 1])); mxb = fmaxf(mxb, fmaxf(s1[i], s1[i + 1])); }
                float mx = fmaxf(mxa, mxb) * sc_;
                mx = half_max(mx);
                mn = fmaxf(mrow, mx);
                const float alpha = __builtin_amdgcn_exp2f(mrow - mn); mrow = mn; lsum *= alpha;
#pragma unroll
                for (int i = 0; i < 16; ++i) { o0[i] *= alpha; o1[i] *= alpha; }
            }
            if (BOUND) {
                f32x2 ps2 = {0.f, 0.f}; const f32x2 sc2 = {sc_, sc_}, mn2 = {mn, mn};
#pragma unroll
                for (int i = 0; i < 16; i += 2) {
                    f32x2 a = {s0[i], s0[i + 1]}, b = {s1[i], s1[i + 1]}; a = a * sc2 - mn2; b = b * sc2 - mn2;
                    a.x = __builtin_amdgcn_exp2f(a.x); a.y = __builtin_amdgcn_exp2f(a.y); b.x = __builtin_amdgcn_exp2f(b.x); b.y = __builtin_amdgcn_exp2f(b.y);
                    s0[i] = a.x; s0[i + 1] = a.y; s1[i] = b.x; s1[i + 1] = b.y; ps2 += a + b; }
                lsum += ps2.x + ps2.y;
            } else {
                float psa = 0.f, psb = 0.f;
#pragma unroll
                for (int i = 0; i < 16; ++i) { s0[i] = __builtin_amdgcn_exp2f(__builtin_fmaf(s0[i], sc_, -mn)); s1[i] = __builtin_amdgcn_exp2f(__builtin_fmaf(s1[i], sc_, -mn)); psa += s0[i]; psb += s1[i]; }
                lsum += psa + psb;
            }
            bf16x8 pf[2][2];
#pragma unroll
            for (int st = 0; st < 2; ++st) { v4u a, b;
                a.x = pk2(s0[8 * st + 0], s0[8 * st + 1]); a.y = pk2(s0[8 * st + 2], s0[8 * st + 3]); a.z = pk2(s0[8 * st + 4], s0[8 * st + 5]); a.w = pk2(s0[8 * st + 6], s0[8 * st + 7]);
                b.x = pk2(s1[8 * st + 0], s1[8 * st + 1]); b.y = pk2(s1[8 * st + 2], s1[8 * st + 3]); b.z = pk2(s1[8 * st + 4], s1[8 * st + 5]); b.w = pk2(s1[8 * st + 6], s1[8 * st + 7]);
                pf[0][st] = __builtin_bit_cast(bf16x8, a); pf[1][st] = __builtin_bit_cast(bf16x8, b); }
#pragma unroll
            for (int sub = 0; sub < 2; ++sub)
#pragma unroll
                for (int st = 0; st < 2; ++st) {
                    const bf16x8 v0 = vf0[sub][st], v1 = vf1[sub][st];
                    o0 = __builtin_amdgcn_mfma_f32_32x32x16_bf16(v0, pf[sub][st], o0, 0, 0, 0); o1 = __builtin_amdgcn_mfma_f32_32x32x16_bf16(v1, pf[sub][st], o1, 0, 0, 0);
                }
        }
    }
#undef AT_LOAD
#undef AT_WRITE
    const float linv = 1.f / half_sum(lsum);
    bf16* orow = P + (size_t)(c.q_m0 + r) * PW;
    v2u zq[4][2];
#pragma unroll
    for (int g = 0; g < 4; ++g)
#pragma unroll
        for (int dt = 0; dt < 2; ++dt) zq[g][dt] = *(const v2u*)(orow + c.zcol + 32 * dt + 8 * g + 4 * h);
#pragma unroll
    for (int g = 0; g < 4; ++g) {
#pragma unroll
        for (int dt = 0; dt < 2; ++dt) { const int d = 32 * dt + 8 * g + 4 * h;
            const v2u zz = zq[g][dt];
            float y0, y1, y2, y3;
            if (dt == 0) { y0 = o0[4 * g]; y1 = o0[4 * g + 1]; y2 = o0[4 * g + 2]; y3 = o0[4 * g + 3]; } else { y0 = o1[4 * g]; y1 = o1[4 * g + 1]; y2 = o1[4 * g + 2]; y3 = o1[4 * g + 3]; }
            v2u w; w.x = pk2(y0 * linv * silu(bflo(zz.x)), y1 * linv * silu(bfhi(zz.x))); w.y = pk2(y2 * linv * silu(bflo(zz.y)), y3 * linv * silu(bfhi(zz.y)));
            if (!F.dry) *(v2u*)(orow + c.qcol + d) = w; }
    }
    __syncthreads();
}

constexpr int GQ_SLOT = 8192, GQ_K = 0, GQ_V = 3 * GQ_SLOT, GQ_WSF = 6 * GQ_SLOT, GQ_OST = GQ_WSF + 8 * 256, GQ_OROW = 68, GQ_OSTW = 32 * GQ_OROW * 4, GQ_NT = 72;
static_assert(GQ_OST + 8 * GQ_OSTW <= RING_BYTES, "gqa unit LDS");
__device__ __forceinline__ int gq_crow(int r, int hi) { return (r & 3) + 8 * (r >> 2) + 4 * hi; }
__device__ __forceinline__ unsigned gq_cvtpk(float lo, float hi) { unsigned r; asm("v_cvt_pk_bf16_f32 %0, %1, %2" : "=v"(r) : "v"(lo), "v"(hi)); return r; }
__device__ __forceinline__ void gq_glds16(const void* g, unsigned lds_base) {
    unsigned sv; asm volatile("s_mov_b32 %0, m0\n\ts_mov_b32 m0, %2\n\ts_nop 0\n\tglobal_load_lds_dwordx4 %1, off\n\ts_mov_b32 m0, %0" : "=&s"(sv) : "v"(g), "s"(lds_base) : "memory"); }
typedef const LAS unsigned char* gq_lptr;
__device__ __forceinline__ void gq_kload2(bf16x8* kf, gq_lptr kp, int d0) { kf[2 * d0] = *(const LAS bf16x8*)(kp + d0 * 2048); kf[2 * d0 + 1] = *(const LAS bf16x8*)(kp + d0 * 2048 + 512); }
__device__ __forceinline__ s16x4 gq_vtr(gq_lptr p) { return __builtin_amdgcn_ds_read_tr16_b64_v4i16((LAS s16x4*)p); }
#define GQ_SBAR() __builtin_amdgcn_sched_barrier(0)
#define GQ_PIN(x) asm volatile("" : "+v"(x))
#define GQ_MFMA(a, b, c) __builtin_amdgcn_mfma_f32_32x32x16_bf16(a, b, c, 0, 0, 0)
#define GQ_WAIT_BAR(N) asm volatile("s_waitcnt vmcnt(" #N ") lgkmcnt(0)\n\ts_barrier" ::: "memory")
__device__ __forceinline__ void gqa_unit(Frame& F, int b, int kv, int qb, const float kn2) {
    int lane_ = F.lane; asm volatile("" : "+v"(lane_));
    const int lane = lane_, r32 = lane & 31, hi = lane >> 5, wid = __builtin_amdgcn_readfirstlane(F.wave_s);
    LAS unsigned char* lds = F.lds; bf16* P = F.PROJ();
    const int mb = TCTX + b * LAT_L, hd = kv * 2 + (wid >> 2), q_m0 = mb + qb * 128 + (wid & 3) * 32, qcol = C_DQ + hd * 64, zcol = C_DZ + hd * 64;
    const unsigned lds0 = (unsigned)(size_t)lds;
    const char* baseA = (const char*)(P + (size_t)mb * PW + C_DK + kv * 64);
    const char* baseB = (const char*)((const bf16*)(F.ws + WS_GQC) + (size_t)b * PAST * PW + kv * 64);
    const int vrow = 16 * (wid & 3) + (lane >> 2), vc = (wid >> 2) * 32 + (lane & 3) * 8;
    const unsigned kvoA = (unsigned)(lane * PW + wid * 8) * 2u, vvoA = (unsigned)(vrow * PW + vc + (C_DV - C_DK)) * 2u;
    const unsigned kdst = (unsigned)__builtin_amdgcn_readfirstlane(lds0 + GQ_K + wid * 1024), vdst = (unsigned)__builtin_amdgcn_readfirstlane(lds0 + GQ_V + wid * 1024);
#define GQ_TB(t) (((t) < 64 ? baseA : baseB - (size_t)64 * (64 * PW * 2)) + (size_t)(t) * (64 * PW * 2))
#define GQ_DMA_K(t, slot) gq_glds16(GQ_TB(t) + kvoA, (unsigned)__builtin_amdgcn_readfirstlane(kdst + (slot)))
#define GQ_DMA_V(t, slot) gq_glds16(GQ_TB(t) + vvoA, (unsigned)__builtin_amdgcn_readfirstlane(vdst + (slot)))
    const gq_lptr vp0 = (gq_lptr)lds + GQ_V + ((lane >> 4) & 1) * 32 + (lane & 3) * 8 + (4 * hi + ((lane & 15) >> 2)) * 64;
    const gq_lptr kp0 = (gq_lptr)lds + GQ_K + hi * 1024 + r32 * 16;
    LAS float* wsf = (LAS float*)(lds + GQ_WSF) + wid * 64;
    GQ_DMA_K(0, 0); GQ_DMA_V(0, 0); GQ_DMA_K(1, GQ_SLOT);
    bf16x8 qr[4];
    { const bf16* qp = P + (size_t)(q_m0 + r32) * PW + qcol + 8 * hi;
#pragma unroll
      for (int d0 = 0; d0 < 4; ++d0) qr[d0] = *(const bf16x8*)(qp + 16 * d0); }
    GQ_DMA_K(2, 2 * GQ_SLOT);
    float q2 = 0.f;
#pragma unroll
    for (int d0 = 0; d0 < 4; ++d0) { const v4u w = __builtin_bit_cast(v4u, qr[d0]);
        q2 += bflo(w.x) * bflo(w.x) + bfhi(w.x) * bfhi(w.x) + bflo(w.y) * bflo(w.y) + bfhi(w.y) * bfhi(w.y) + bflo(w.z) * bflo(w.z) + bfhi(w.z) * bfhi(w.z) + bflo(w.w) * bflo(w.w) + bfhi(w.w) * bfhi(w.w); }
    q2 = half_sum(q2);
    const float nmb = -sqrtf(q2 * kn2) * 1.02f;
    f32x16 nmb16;
#pragma unroll
    for (int i = 0; i < 16; ++i) nmb16[i] = nmb;
    GQ_PIN(nmb16);
    float l_reg = 0.f; f32x16 o[2];
#pragma unroll
    for (int i = 0; i < 16; ++i) { o[0][i] = 0.f; o[1][i] = 0.f; }
    f32x16 pA0, pA1, pB0, pB1; bf16x8 kf[8]; s16x4 vlo[8], vhi[8]; v4u pw0, pw1, pw2, pw3;
    int sl_prev = 0, sl_cur = 0, sl_next = GQ_SLOT;
#define GQ_ROT() do { sl_prev = sl_cur; sl_cur = sl_next; sl_next = (sl_next == 2 * GQ_SLOT) ? 0 : sl_next + GQ_SLOT; } while (0)
    GQ_WAIT_BAR(3);
#pragma unroll
    for (int d0 = 0; d0 < 4; ++d0) gq_kload2(kf, kp0, d0);
    pA0 = GQ_MFMA(kf[0], qr[0], nmb16); pA1 = GQ_MFMA(kf[1], qr[0], nmb16); pA0 = GQ_MFMA(kf[2], qr[1], pA0); pA1 = GQ_MFMA(kf[3], qr[1], pA1);
    pA0 = GQ_MFMA(kf[4], qr[2], pA0); pA1 = GQ_MFMA(kf[5], qr[2], pA1); pA0 = GQ_MFMA(kf[6], qr[3], pA0); pA1 = GQ_MFMA(kf[7], qr[3], pA1);
#pragma unroll
    for (int r = 0; r < 16; ++r) { pA0[r] = __builtin_amdgcn_exp2f(pA0[r]); pA1[r] = __builtin_amdgcn_exp2f(pA1[r]); }
    GQ_WAIT_BAR(0);
    GQ_DMA_K(3, 0); GQ_DMA_V(1, GQ_SLOT); GQ_ROT();
#pragma unroll
    for (int d0 = 0; d0 < 4; ++d0) gq_kload2(kf, kp0 + sl_cur, d0);
    GQ_WAIT_BAR(2);
#define GQ_PKW(Pv, i) gq_cvtpk(Pv[i], Pv[i + 1])
#define GQ_PAF(k) __builtin_bit_cast(bf16x8, pw##k)
#define GQ_VFR(i) (bf16x8){vlo[i][0], vlo[i][1], vlo[i][2], vlo[i][3], vhi[i][0], vhi[i][1], vhi[i][2], vhi[i][3]}
#define GQ_VRD(i) do { vlo[i] = gq_vtr(vp_ + (((i) >> 2) * 4096 + ((i) & 3) * 1024)); vhi[i] = gq_vtr(vp_ + (((i) >> 2) * 4096 + ((i) & 3) * 1024 + 512)); } while (0)
#define GQ_KRD(G, d0) do { if (G) { gq_kload2(kf, kp0 + sl_next, d0); GQ_SBAR(); } } while (0)
#define GQ_GAPA(MF, a0, a1, a2, a3, W0, W1, PWV) do { MF; sacc += a0; sacc += a1; sacc += a2; sacc += a3; W0; W1; GQ_PIN(PWV); GQ_PIN(sacc); GQ_SBAR(); } while (0)
#define GQ_GAPB(MF, X, i) do { MF; X[i] = __builtin_amdgcn_exp2f(X[i]); X[i + 1] = __builtin_amdgcn_exp2f(X[i + 1]); X[i + 2] = __builtin_amdgcn_exp2f(X[i + 2]); X[i + 3] = __builtin_amdgcn_exp2f(X[i + 3]); GQ_PIN(X); GQ_SBAR(); } while (0)
#define GQ_STEP(C0, C1, P0, P1, t, GK, GV, GL) do { GQ_SBAR(); \
    const gq_lptr vp_ = vp0 + sl_prev; \
    GQ_VRD(0); GQ_SBAR(); float sacc = P0[0] + P0[1]; \
                       GQ_GAPA(C0 = GQ_MFMA(kf[0], qr[0], nmb16), P0[2], P0[3], P0[4], P0[5],     pw0[0] = GQ_PKW(P0, 0),  pw0[1] = GQ_PKW(P0, 2),  pw0); \
    GQ_VRD(4); GQ_SBAR(); GQ_GAPA(C1 = GQ_MFMA(kf[1], qr[0], nmb16), P0[6], P0[7], P0[8], P0[9],     pw0[2] = GQ_PKW(P0, 4),  pw0[3] = GQ_PKW(P0, 6),  pw0); \
    GQ_VRD(1); GQ_SBAR(); GQ_GAPA(C0 = GQ_MFMA(kf[2], qr[1], C0),    P0[10], P0[11], P0[12], P0[13], pw1[0] = GQ_PKW(P0, 8),  pw1[1] = GQ_PKW(P0, 10), pw1); \
    GQ_VRD(5); GQ_SBAR(); GQ_GAPA(C1 = GQ_MFMA(kf[3], qr[1], C1),    P0[14], P0[15], P1[0], P1[1],   pw1[2] = GQ_PKW(P0, 12), pw1[3] = GQ_PKW(P0, 14), pw1); \
    GQ_VRD(2); GQ_SBAR(); GQ_GAPA(C0 = GQ_MFMA(kf[4], qr[2], C0),    P1[2], P1[3], P1[4], P1[5],     pw2[0] = GQ_PKW(P1, 0),  pw2[1] = GQ_PKW(P1, 2),  pw2); \
    GQ_VRD(6); GQ_SBAR(); GQ_GAPA(C1 = GQ_MFMA(kf[5], qr[2], C1),    P1[6], P1[7], P1[8], P1[9],     pw2[2] = GQ_PKW(P1, 4),  pw2[3] = GQ_PKW(P1, 6),  pw2); \
    GQ_VRD(3); GQ_SBAR(); GQ_GAPA(C0 = GQ_MFMA(kf[6], qr[3], C0),    P1[10], P1[11], P1[12], P1[13], pw3[0] = GQ_PKW(P1, 8),  pw3[1] = GQ_PKW(P1, 10), pw3); \
    GQ_VRD(7); GQ_SBAR(); GQ_GAPA(C1 = GQ_MFMA(kf[7], qr[3], C1),    P1[14], P1[15], 0.f, 0.f,       pw3[2] = GQ_PKW(P1, 12), pw3[3] = GQ_PKW(P1, 14), pw3); \
    l_reg += sacc; \
    if (GK) GQ_DMA_K((t) + 3, sl_cur); if (GV) GQ_DMA_V((t) + 1, sl_next); \
    GQ_SBAR(); \
    GQ_GAPB(o[0] = GQ_MFMA(GQ_PAF(0), GQ_VFR(0), o[0]), C0, 0);                 GQ_GAPB(o[1] = GQ_MFMA(GQ_PAF(0), GQ_VFR(4), o[1]), C0, 4); \
    GQ_KRD(GL, 0); GQ_GAPB(o[0] = GQ_MFMA(GQ_PAF(1), GQ_VFR(1), o[0]), C0, 8);  GQ_KRD(GL, 1); GQ_GAPB(o[1] = GQ_MFMA(GQ_PAF(1), GQ_VFR(5), o[1]), C0, 12); \
    GQ_KRD(GL, 2); GQ_GAPB(o[0] = GQ_MFMA(GQ_PAF(2), GQ_VFR(2), o[0]), C1, 0);  GQ_KRD(GL, 3); GQ_GAPB(o[1] = GQ_MFMA(GQ_PAF(2), GQ_VFR(6), o[1]), C1, 4); \
    GQ_GAPB(o[0] = GQ_MFMA(GQ_PAF(3), GQ_VFR(3), o[0]), C1, 8);                 GQ_GAPB(o[1] = GQ_MFMA(GQ_PAF(3), GQ_VFR(7), o[1]), C1, 12); \
    } while (0)
    int t = 1;
    for (; t + 5 < GQ_NT; t += 2) {
        GQ_STEP(pB0, pB1, pA0, pA1, t, true, true, true);     GQ_WAIT_BAR(2); GQ_ROT();
        GQ_STEP(pA0, pA1, pB0, pB1, t + 1, true, true, true); GQ_WAIT_BAR(2); GQ_ROT();
    }
#define GQ_ENDW(tt) do { if ((tt) + 3 < GQ_NT) { GQ_WAIT_BAR(2); } else if ((tt) + 2 < GQ_NT) { GQ_WAIT_BAR(1); } else { GQ_WAIT_BAR(0); } } while (0)
    for (; t + 1 < GQ_NT; t += 2) {
        GQ_STEP(pB0, pB1, pA0, pA1, t, (t + 3 < GQ_NT), (t + 1 < GQ_NT), (t + 1 < GQ_NT));         GQ_ENDW(t);     GQ_ROT();
        GQ_STEP(pA0, pA1, pB0, pB1, t + 1, (t + 4 < GQ_NT), (t + 2 < GQ_NT), (t + 2 < GQ_NT));     GQ_ENDW(t + 1); GQ_ROT();
    }
    GQ_STEP(pB0, pB1, pA0, pA1, GQ_NT - 1, false, false, false);
    { float sacc = pB0[0] + pB0[1];
#pragma unroll
      for (int r = 2; r < 16; ++r) sacc += pB0[r];
#pragma unroll
      for (int r = 0; r < 16; ++r) sacc += pB1[r];
      l_reg += sacc;
      pw0 = (v4u){GQ_PKW(pB0, 0), GQ_PKW(pB0, 2), GQ_PKW(pB0, 4), GQ_PKW(pB0, 6)}; pw1 = (v4u){GQ_PKW(pB0, 8), GQ_PKW(pB0, 10), GQ_PKW(pB0, 12), GQ_PKW(pB0, 14)};
      pw2 = (v4u){GQ_PKW(pB1, 0), GQ_PKW(pB1, 2), GQ_PKW(pB1, 4), GQ_PKW(pB1, 6)}; pw3 = (v4u){GQ_PKW(pB1, 8), GQ_PKW(pB1, 10), GQ_PKW(pB1, 12), GQ_PKW(pB1, 14)};
      const gq_lptr vp_ = vp0 + sl_cur;
#pragma unroll
      for (int i = 0; i < 8; ++i) GQ_VRD(i);
      o[0] = GQ_MFMA(GQ_PAF(0), GQ_VFR(0), o[0]); o[1] = GQ_MFMA(GQ_PAF(0), GQ_VFR(4), o[1]); o[0] = GQ_MFMA(GQ_PAF(1), GQ_VFR(1), o[0]); o[1] = GQ_MFMA(GQ_PAF(1), GQ_VFR(5), o[1]);
      o[0] = GQ_MFMA(GQ_PAF(2), GQ_VFR(2), o[0]); o[1] = GQ_MFMA(GQ_PAF(2), GQ_VFR(6), o[1]); o[0] = GQ_MFMA(GQ_PAF(3), GQ_VFR(3), o[0]); o[1] = GQ_MFMA(GQ_PAF(3), GQ_VFR(7), o[1]); }
    l_reg = half_sum(l_reg);
    if (hi == 0) wsf[r32] = l_reg;
    LDS_WAIT();
    LAS float* stg = (LAS float*)(lds + GQ_OST + wid * GQ_OSTW);
    float rl[16];
#pragma unroll
    for (int r = 0; r < 16; ++r) rl[r] = wsf[gq_crow(r, hi)];
#pragma unroll
    for (int r = 0; r < 16; ++r) { const int orow = gq_crow(r, hi); const float rli = __builtin_amdgcn_rcpf(rl[r]);
        stg[orow * GQ_OROW + r32] = o[0][r] * rli; stg[orow * GQ_OROW + 32 + r32] = o[1][r] * rli; }
    LDS_WAIT();
    v4u zq[4];
#pragma unroll
    for (int i = 0; i < 4; ++i) zq[i] = *(const v4u*)(P + (size_t)(q_m0 + i * 8 + (lane >> 3)) * PW + zcol + (lane & 7) * 8);
#pragma unroll
    for (int i = 0; i < 4; ++i) { const int row = i * 8 + (lane >> 3), ch = lane & 7;
        const f32x4 a = *(const LAS f32x4*)(stg + row * GQ_OROW + ch * 8), c = *(const LAS f32x4*)(stg + row * GQ_OROW + ch * 8 + 4);
        bf16* orow = P + (size_t)(q_m0 + row) * PW; const v4u zz = zq[i]; v4u w;
        w.x = pk2(a.x * silu(bflo(zz.x)), a.y * silu(bfhi(zz.x))); w.y = pk2(a.z * silu(bflo(zz.y)), a.w * silu(bfhi(zz.y)));
        w.z = pk2(c.x * silu(bflo(zz.z)), c.y * silu(bfhi(zz.z))); w.w = pk2(c.z * silu(bflo(zz.w)), c.w * silu(bfhi(zz.w)));
        if (!F.dry) *(v4u*)(orow + qcol + ch * 8) = w; }
    asm volatile("s_waitcnt lgkmcnt(0)\n\ts_barrier" ::: "memory");
#undef GQ_TB
#undef GQ_DMA_K
#undef GQ_DMA_V
#undef GQ_ROT
#undef GQ_PKW
#undef GQ_PAF
#undef GQ_VFR
#undef GQ_VRD
#undef GQ_KRD
#undef GQ_GAPA
#undef GQ_GAPB
#undef GQ_STEP
#undef GQ_ENDW
}

constexpr int NA_BIAS = GQ_OST + 8 * GQ_OSTW;
constexpr float NA_THR = 8.f;
static_assert(NA_BIAS + 465 * 4 <= RING_BYTES, "na unit LDS");
__device__ __forceinline__ float na_rowmax(const f32x16& p0, const f32x16& p1) {
    float a = fmaxf(fmaxf(p0[0], p0[1]), p1[0]), b = fmaxf(fmaxf(p0[2], p0[3]), p1[1]); a = fmaxf(fmaxf(a, p1[2]), p1[3]);
#pragma unroll
    for (int r = 4; r < 16; r += 4) { a = fmaxf(fmaxf(a, p0[r]), p0[r + 1]); b = fmaxf(fmaxf(b, p0[r + 2]), p0[r + 3]); a = fmaxf(fmaxf(a, p1[r]), p1[r + 1]); b = fmaxf(fmaxf(b, p1[r + 2]), p1[r + 3]); }
    return half_max(fmaxf(a, b)); }
__device__ __forceinline__ void na_unit(Frame& F, int l, int it) {
    int lane_ = F.lane; asm volatile("" : "+v"(lane_));
    const int lane = lane_, r32 = lane & 31, hi = lane >> 5, wid = __builtin_amdgcn_readfirstlane(F.wave_s);
    LAS unsigned char* lds = F.lds; bf16* P = F.PROJ();
    const int b = it >> 6, hd = (it >> 4) & 3, rg = it & 15, r0 = rg * 4, mb = TCTX + b * LAT_L;
    const int R0 = min(max(r0 - 4, 0), 56), R1 = min(max(r0 + 3 - 4, 0), 56) + 7, nA = R1 - R0 + 1, NT = 8 + nA + ((8 + nA) & 1);
    const int na_r = r0 + (wid >> 1), qc0 = (wid & 1) * 32, q_m0 = mb + na_r * 64 + qc0, qcol = C_BQ + hd * 64, zcol = C_BZ + hd * 64;
    const int sr = min(max(na_r - 4, 0), 56), qc = qc0 + r32, sc = min(max(qc - 8, 0), 48);
    { const float* rb = inp(F, I_NABIAS) + (size_t)(l * 4 + hd) * 465; LAS float* bt = (LAS float*)(lds + NA_BIAS); const int ti = (wid << 6) | lane; if (ti < 465) bt[ti] = rb[ti] * 1.44269504088896f; }
    const unsigned lds0 = (unsigned)(size_t)lds;
    const char* baseA = (const char*)(P + (size_t)(mb + R0 * 64) * PW + C_BK + hd * 64);
    const char* baseB = (const char*)((const bf16*)(F.ws + WS_NAC) + (size_t)(l * 8 + b) * PAST * PW + hd * 64);
    const int vrow = 16 * (wid & 3) + (lane >> 2), vc = (wid >> 2) * 32 + (lane & 3) * 8;
    const unsigned kvoA = (unsigned)(lane * PW + wid * 8) * 2u, vvoA = (unsigned)(vrow * PW + vc + (C_BV - C_BK)) * 2u;
    const unsigned kdst = (unsigned)__builtin_amdgcn_readfirstlane(lds0 + GQ_K + wid * 1024), vdst = (unsigned)__builtin_amdgcn_readfirstlane(lds0 + GQ_V + wid * 1024);
#define NA_TB(t) ((t) < 8 ? baseB + (size_t)(t) * (64 * PW * 2) : baseA + (size_t)min((t) - 8, nA - 1) * (64 * PW * 2))
#define NA_DMA_K(t, slot) gq_glds16(NA_TB(t) + kvoA, (unsigned)__builtin_amdgcn_readfirstlane(kdst + (slot)))
#define NA_DMA_V(t, slot) gq_glds16(NA_TB(t) + vvoA, (unsigned)__builtin_amdgcn_readfirstlane(vdst + (slot)))
    const gq_lptr vp0 = (gq_lptr)lds + GQ_V + ((lane >> 4) & 1) * 32 + (lane & 3) * 8 + (4 * hi + ((lane & 15) >> 2)) * 64;
    const gq_lptr kp0 = (gq_lptr)lds + GQ_K + hi * 1024 + r32 * 16;
    LAS float* wsf = (LAS float*)(lds + GQ_WSF) + wid * 64;
    NA_DMA_K(0, 0); NA_DMA_V(0, 0); NA_DMA_K(1, GQ_SLOT);
    bf16x8 qr[4];
    { const bf16* qp = P + (size_t)(q_m0 + r32) * PW + qcol + 8 * hi;
#pragma unroll
      for (int d0 = 0; d0 < 4; ++d0) qr[d0] = *(const bf16x8*)(qp + 16 * d0); }
    NA_DMA_K(2, 2 * GQ_SLOT);
    float mhat = 0.f, l_reg = 0.f; f32x16 o[2];
#pragma unroll
    for (int i = 0; i < 16; ++i) { o[0][i] = 0.f; o[1][i] = 0.f; }
    bool resc = false;
    f32x16 pA0, pA1, pB0, pB1, nmb16; bf16x8 kf[8]; s16x4 vlo[8], vhi[8]; v4u pw0, pw1, pw2, pw3;
    int sl_prev = 0, sl_cur = 0, sl_next = GQ_SLOT;
#define NA_ROT() do { sl_prev = sl_cur; sl_cur = sl_next; sl_next = (sl_next == 2 * GQ_SLOT) ? 0 : sl_next + GQ_SLOT; } while (0)
#define NA_RESC() do { if (resc) { _Pragma("unroll") for (int r_ = 0; r_ < 16; ++r_) { const float f_ = wsf[gq_crow(r_, hi)]; o[0][r_] *= f_; o[1][r_] *= f_; } } } while (0)
    GQ_WAIT_BAR(3);
#pragma unroll
    for (int d0 = 0; d0 < 4; ++d0) gq_kload2(kf, kp0, d0);
    { f32x16 z16;
#pragma unroll
      for (int i = 0; i < 16; ++i) z16[i] = 0.f;
      pA0 = GQ_MFMA(kf[0], qr[0], z16); pA1 = GQ_MFMA(kf[1], qr[0], z16); }
    pA0 = GQ_MFMA(kf[2], qr[1], pA0); pA1 = GQ_MFMA(kf[3], qr[1], pA1);
    pA0 = GQ_MFMA(kf[4], qr[2], pA0); pA1 = GQ_MFMA(kf[5], qr[2], pA1); pA0 = GQ_MFMA(kf[6], qr[3], pA0); pA1 = GQ_MFMA(kf[7], qr[3], pA1);
    mhat = na_rowmax(pA0, pA1);
#pragma unroll
    for (int r = 0; r < 16; ++r) { pA0[r] = __builtin_amdgcn_exp2f(pA0[r] - mhat); pA1[r] = __builtin_amdgcn_exp2f(pA1[r] - mhat); }
#pragma unroll
    for (int i = 0; i < 16; ++i) nmb16[i] = -mhat;
    GQ_PIN(nmb16);
    GQ_WAIT_BAR(0);
    NA_DMA_K(3, 0); NA_DMA_V(1, GQ_SLOT); NA_ROT();
#pragma unroll
    for (int d0 = 0; d0 < 4; ++d0) gq_kload2(kf, kp0 + sl_cur, d0);
    GQ_WAIT_BAR(2);
#define NA_PKW(Pv, i) gq_cvtpk(Pv[i], Pv[i + 1])
#define NA_PAF(k) __builtin_bit_cast(bf16x8, pw##k)
#define NA_VFR(i) (bf16x8){vlo[i][0], vlo[i][1], vlo[i][2], vlo[i][3], vhi[i][0], vhi[i][1], vhi[i][2], vhi[i][3]}
#define NA_VRD(i) do { vlo[i] = gq_vtr(vp_ + (((i) >> 2) * 4096 + ((i) & 3) * 1024)); vhi[i] = gq_vtr(vp_ + (((i) >> 2) * 4096 + ((i) & 3) * 1024 + 512)); } while (0)
#define NA_KRD(G, d0) do { if (G) { gq_kload2(kf, kp0 + sl_next, d0); GQ_SBAR(); } } while (0)
#define NA_GAPA(MF, a0, a1, a2, a3, W0, W1, PWV) do { MF; sacc += a0; sacc += a1; sacc += a2; sacc += a3; W0; W1; GQ_PIN(PWV); GQ_PIN(sacc); GQ_SBAR(); } while (0)
#define NA_GAPB(MF, X, i) do { MF; X[i] = __builtin_amdgcn_exp2f(X[i]); X[i + 1] = __builtin_amdgcn_exp2f(X[i + 1]); X[i + 2] = __builtin_amdgcn_exp2f(X[i + 2]); X[i + 3] = __builtin_amdgcn_exp2f(X[i + 3]); GQ_PIN(X); GQ_SBAR(); } while (0)
#define NA_HOOK(C0, C1, t) do { const int w_ = (t) - 8, R_ = R0 + w_; \
        if (w_ < nA && R_ >= sr && R_ <= sr + 7) { \
            const LAS float* bt_ = (const LAS float*)(lds + NA_BIAS) + (R_ - na_r + 7) * 31 + 15 - qc + 4 * hi; const unsigned kb_ = (unsigned)(4 * hi - sc); \
              \
            float b_[16]; \
            _Pragma("unroll") for (int i_ = 0; i_ < 16; ++i_) b_[i_] = bt_[(i_ & 3) + 8 * (i_ >> 2)]; \
            _Pragma("unroll") for (int i_ = 0; i_ < 16; ++i_) asm volatile("" : "+v"(b_[i_])); \
            _Pragma("unroll") for (int i_ = 0; i_ < 16; ++i_) { const float a_ = C0[i_] + b_[i_]; C0[i_] = (kb_ + (unsigned)((i_ & 3) + 8 * (i_ >> 2)) < 16u) ? a_ : -1.0e30f; } \
            _Pragma("unroll") for (int i_ = 0; i_ < 16; ++i_) b_[i_] = bt_[32 + (i_ & 3) + 8 * (i_ >> 2)]; \
            _Pragma("unroll") for (int i_ = 0; i_ < 16; ++i_) asm volatile("" : "+v"(b_[i_])); \
            _Pragma("unroll") for (int i_ = 0; i_ < 16; ++i_) { const float a_ = C1[i_] + b_[i_]; C1[i_] = (kb_ + (unsigned)(32 + (i_ & 3) + 8 * (i_ >> 2)) < 16u) ? a_ : -1.0e30f; } \
        } else { _Pragma("unroll") for (int i_ = 0; i_ < 16; ++i_) { C0[i_] = -1.0e30f; C1[i_] = -1.0e30f; } } } while (0)
#define NA_STEP(C0, C1, P0, P1, t, GK, GV, GL) do { GQ_SBAR(); \
    const gq_lptr vp_ = vp0 + sl_prev; \
    NA_VRD(0); GQ_SBAR(); float sacc = P0[0] + P0[1]; \
                          NA_GAPA(C0 = GQ_MFMA(kf[0], qr[0], nmb16), P0[2], P0[3], P0[4], P0[5],     pw0[0] = NA_PKW(P0, 0),  pw0[1] = NA_PKW(P0, 2),  pw0); \
    NA_VRD(4); GQ_SBAR(); NA_GAPA(C1 = GQ_MFMA(kf[1], qr[0], nmb16), P0[6], P0[7], P0[8], P0[9],     pw0[2] = NA_PKW(P0, 4),  pw0[3] = NA_PKW(P0, 6),  pw0); \
    NA_VRD(1); GQ_SBAR(); NA_GAPA(C0 = GQ_MFMA(kf[2], qr[1], C0),    P0[10], P0[11], P0[12], P0[13], pw1[0] = NA_PKW(P0, 8),  pw1[1] = NA_PKW(P0, 10), pw1); \
    NA_VRD(5); GQ_SBAR(); NA_GAPA(C1 = GQ_MFMA(kf[3], qr[1], C1),    P0[14], P0[15], P1[0], P1[1],   pw1[2] = NA_PKW(P0, 12), pw1[3] = NA_PKW(P0, 14), pw1); \
    NA_VRD(2); GQ_SBAR(); NA_GAPA(C0 = GQ_MFMA(kf[4], qr[2], C0),    P1[2], P1[3], P1[4], P1[5],     pw2[0] = NA_PKW(P1, 0),  pw2[1] = NA_PKW(P1, 2),  pw2); \
    NA_VRD(6); GQ_SBAR(); NA_GAPA(C1 = GQ_MFMA(kf[5], qr[2], C1),    P1[6], P1[7], P1[8], P1[9],     pw2[2] = NA_PKW(P1, 4),  pw2[3] = NA_PKW(P1, 6),  pw2); \
    NA_VRD(3); GQ_SBAR(); NA_GAPA(C0 = GQ_MFMA(kf[6], qr[3], C0),    P1[10], P1[11], P1[12], P1[13], pw3[0] = NA_PKW(P1, 8),  pw3[1] = NA_PKW(P1, 10), pw3); \
    NA_VRD(7); GQ_SBAR(); NA_GAPA(C1 = GQ_MFMA(kf[7], qr[3], C1),    P1[14], P1[15], 0.f, 0.f,       pw3[2] = NA_PKW(P1, 12), pw3[3] = NA_PKW(P1, 14), pw3); \
    l_reg += sacc; \
    if (GK) NA_DMA_K((t) + 3, sl_cur); if (GV) NA_DMA_V((t) + 1, sl_next); \
    if ((t) >= 8) NA_HOOK(C0, C1, t); \
    { const float rm = na_rowmax(C0, C1); resc = false;                                             \
      if (__builtin_expect(__any(rm > NA_THR), 0)) { const float dl = fmaxf(rm, 0.f); mhat += dl;     \
          const float f = __builtin_amdgcn_exp2f(-dl); l_reg *= f; if (hi == 0) wsf[r32] = f; resc = true; \
          _Pragma("unroll") for (int i_ = 0; i_ < 16; ++i_) { C0[i_] -= dl; C1[i_] -= dl; nmb16[i_] = -mhat; } GQ_PIN(nmb16); } } \
    GQ_SBAR(); \
    NA_GAPB(o[0] = GQ_MFMA(NA_PAF(0), NA_VFR(0), o[0]), C0, 0);                 NA_GAPB(o[1] = GQ_MFMA(NA_PAF(0), NA_VFR(4), o[1]), C0, 4); \
    NA_KRD(GL, 0); NA_GAPB(o[0] = GQ_MFMA(NA_PAF(1), NA_VFR(1), o[0]), C0, 8);  NA_KRD(GL, 1); NA_GAPB(o[1] = GQ_MFMA(NA_PAF(1), NA_VFR(5), o[1]), C0, 12); \
    NA_KRD(GL, 2); NA_GAPB(o[0] = GQ_MFMA(NA_PAF(2), NA_VFR(2), o[0]), C1, 0);  NA_KRD(GL, 3); NA_GAPB(o[1] = GQ_MFMA(NA_PAF(2), NA_VFR(6), o[1]), C1, 4); \
    NA_GAPB(o[0] = GQ_MFMA(NA_PAF(3), NA_VFR(3), o[0]), C1, 8);                 NA_GAPB(o[1] = GQ_MFMA(NA_PAF(3), NA_VFR(7), o[1]), C1, 12); \
    } while (0)
#define NA_ENDW(tt) do { if ((tt) + 3 < NT) { GQ_WAIT_BAR(2); } else if ((tt) + 2 < NT) { GQ_WAIT_BAR(1); } else { GQ_WAIT_BAR(0); } } while (0)
    int t = 1;
    for (; t + 5 < NT; t += 2) {
        NA_STEP(pB0, pB1, pA0, pA1, t, true, true, true);     GQ_WAIT_BAR(2); NA_RESC(); NA_ROT();
        NA_STEP(pA0, pA1, pB0, pB1, t + 1, true, true, true); GQ_WAIT_BAR(2); NA_RESC(); NA_ROT();
    }
    for (; t + 1 < NT; t += 2) {
        NA_STEP(pB0, pB1, pA0, pA1, t, (t + 3 < NT), (t + 1 < NT), (t + 1 < NT));         NA_ENDW(t);     NA_RESC(); NA_ROT();
        NA_STEP(pA0, pA1, pB0, pB1, t + 1, (t + 4 < NT), (t + 2 < NT), (t + 2 < NT));     NA_ENDW(t + 1); NA_RESC(); NA_ROT();
    }
    NA_STEP(pB0, pB1, pA0, pA1, NT - 1, false, false, false); NA_RESC();
    { float sacc = pB0[0] + pB0[1];
#pragma unroll
      for (int r = 2; r < 16; ++r) sacc += pB0[r];
#pragma unroll
      for (int r = 0; r < 16; ++r) sacc += pB1[r];
      l_reg += sacc;
      pw0 = (v4u){NA_PKW(pB0, 0), NA_PKW(pB0, 2), NA_PKW(pB0, 4), NA_PKW(pB0, 6)}; pw1 = (v4u){NA_PKW(pB0, 8), NA_PKW(pB0, 10), NA_PKW(pB0, 12), NA_PKW(pB0, 14)};
      pw2 = (v4u){NA_PKW(pB1, 0), NA_PKW(pB1, 2), NA_PKW(pB1, 4), NA_PKW(pB1, 6)}; pw3 = (v4u){NA_PKW(pB1, 8), NA_PKW(pB1, 10), NA_PKW(pB1, 12), NA_PKW(pB1, 14)};
      const gq_lptr vp_ = vp0 + sl_cur;
#pragma unroll
      for (int i = 0; i < 8; ++i) NA_VRD(i);
      o[0] = GQ_MFMA(NA_PAF(0), NA_VFR(0), o[0]); o[1] = GQ_MFMA(NA_PAF(0), NA_VFR(4), o[1]); o[0] = GQ_MFMA(NA_PAF(1), NA_VFR(1), o[0]); o[1] = GQ_MFMA(NA_PAF(1), NA_VFR(5), o[1]);
      o[0] = GQ_MFMA(NA_PAF(2), NA_VFR(2), o[0]); o[1] = GQ_MFMA(NA_PAF(2), NA_VFR(6), o[1]); o[0] = GQ_MFMA(NA_PAF(3), NA_VFR(3), o[0]); o[1] = GQ_MFMA(NA_PAF(3), NA_VFR(7), o[1]); }
    l_reg = half_sum(l_reg);
    LDS_WAIT();
    if (hi == 0) wsf[r32] = l_reg;
    LDS_WAIT();
    LAS float* stg = (LAS float*)(lds + GQ_OST + wid * GQ_OSTW);
    float rl[16];
#pragma unroll
    for (int r = 0; r < 16; ++r) rl[r] = wsf[gq_crow(r, hi)];
#pragma unroll
    for (int r = 0; r < 16; ++r) { const int orow = gq_crow(r, hi); const float rli = __builtin_amdgcn_rcpf(rl[r]);
        stg[orow * GQ_OROW + r32] = o[0][r] * rli; stg[orow * GQ_OROW + 32 + r32] = o[1][r] * rli; }
    LDS_WAIT();
    v4u zq[4];
#pragma unroll
    for (int i = 0; i < 4; ++i) zq[i] = *(const v4u*)(P + (size_t)(q_m0 + i * 8 + (lane >> 3)) * PW + zcol + (lane & 7) * 8);
#pragma unroll
    for (int i = 0; i < 4; ++i) { const int row = i * 8 + (lane >> 3), ch = lane & 7;
        const f32x4 a = *(const LAS f32x4*)(stg + row * GQ_OROW + ch * 8), c = *(const LAS f32x4*)(stg + row * GQ_OROW + ch * 8 + 4);
        bf16* orow = P + (size_t)(q_m0 + row) * PW; const v4u zz = zq[i]; v4u w;
        w.x = pk2(a.x * silu(bflo(zz.x)), a.y * silu(bfhi(zz.x))); w.y = pk2(a.z * silu(bflo(zz.y)), a.w * silu(bfhi(zz.y)));
        w.z = pk2(c.x * silu(bflo(zz.z)), c.y * silu(bfhi(zz.z))); w.w = pk2(c.z * silu(bflo(zz.w)), c.w * silu(bfhi(zz.w)));
        if (!F.dry) *(v4u*)(orow + qcol + ch * 8) = w; }
    asm volatile("s_waitcnt lgkmcnt(0)\n\ts_barrier" ::: "memory");
#undef NA_TB
#undef NA_DMA_K
#undef NA_DMA_V
#undef NA_ROT
#undef NA_RESC
#undef NA_PKW
#undef NA_PAF
#undef NA_VFR
#undef NA_VRD
#undef NA_KRD
#undef NA_GAPA
#undef NA_GAPB
#undef NA_HOOK
#undef NA_STEP
#undef NA_ENDW
}
__device__ __forceinline__ void at_ctxB(Frame& F, int it) { const int b = it >> 2, hd = it & 3; AttnCfg c{};
    c.q_m0 = b * 256 + F.wave * 32; c.qcol = C_BQ + hd * 64; c.zcol = C_BZ + hd * 64; c.nA = 4; c.kA_m0 = b * 256; c.kcol = C_BK + hd * 64; c.vcol = C_BV + hd * 64; c.nB = 0; c.strideB = 0; c.kB = nullptr; c.vB = nullptr; c.sc = 1.f;
    attn_item<false>(F, c); }
__device__ __forceinline__ void at_ctxD(Frame& F, int l, int it) { const int b = it >> 2, kv = (it >> 1) & 1, qb = it & 1, hd = kv * 2 + (F.wave >> 2); AttnCfg c{};
    c.q_m0 = b * 256 + qb * 128 + (F.wave & 3) * 32; c.qcol = C_DQ + hd * 64; c.zcol = C_DZ + hd * 64; c.nA = 4; c.kA_m0 = b * 256; c.kcol = C_DK + kv * 64; c.vcol = C_DV + kv * 64; c.nB = 0; c.strideB = 0; c.kB = nullptr; c.vB = nullptr; c.sc = 1.f;
    const float gk = fabsf(inp(F, I_GKG)[l * 64 + F.lane]); float gm = gk;
    gm = wave_max(gm);
    float gq = fabsf(inp(F, I_GQG)[l * 64 + F.lane]);
    gq = wave_max(gq);
    if (8.f * gq * gm < 40.f) attn_item<false, true>(F, c, 64.f * gm * gm); else attn_item<false>(F, c); }
__device__ __forceinline__ void at_gqa(Frame& F, int l, int it) { const int b = it >> 6, kv = (it >> 5) & 1, qb = it & 31, hd = kv * 2 + (F.wave >> 2), mb = TCTX + b * LAT_L; AttnCfg c{};
    c.q_m0 = mb + qb * 128 + (F.wave & 3) * 32; c.qcol = C_DQ + hd * 64; c.zcol = C_DZ + hd * 64; c.nA = 64; c.kA_m0 = mb; c.kcol = C_DK + kv * 64; c.vcol = C_DV + kv * 64;
    c.nB = 8; c.strideB = 128; const size_t o = ((size_t)(b * 2 + l) * PAST * 2 + kv) * 64; c.kB = inp(F, I_CGK) + o; c.vB = inp(F, I_CGV) + o; c.sc = 1.f;
    const float gk = fabsf(inp(F, I_GKG)[l * 64 + F.lane]); float gm = gk;
    gm = wave_max(gm);
    const float kn2 = fmaxf(64.f * gm * gm, ((const float*)(F.ws + WS_KNC))[(l * 8 + b) * 2 + kv]);
    float gq = fabsf(inp(F, I_GQG)[l * 64 + F.lane]);
    gq = wave_max(gq);
    if (sqrtf(64.f * gq * gq * kn2) * 0.125f < 40.f) gqa_unit(F, b, kv, qb, kn2); else attn_item<false>(F, c); }
__device__ __forceinline__ void at_na(Frame& F, int l, int it) { const int b = it >> 6, hd = (it >> 4) & 3, rg = it & 15, r0 = rg * 4, mb = TCTX + b * LAT_L; AttnCfg c{};
    const int R0 = min(max(r0 - 4, 0), 56), R1 = min(max(r0 + 3 - 4, 0), 56) + 7;
    { const float* rb = inp(F, I_NABIAS) + (size_t)(l * 4 + hd) * 465; LAS float* bt = (LAS float*)(F.lds + AT_BIAS_OFF); for (int i = F.tid; i < 465; i += NTHR) bt[i] = rb[i] * 1.44269504088896f; }
    c.na_r = r0 + (F.wave >> 1); c.na_R0 = R0; c.na_qc0 = (F.wave & 1) * 32;
    c.q_m0 = mb + c.na_r * 64 + c.na_qc0; c.qcol = C_BQ + hd * 64; c.zcol = C_BZ + hd * 64; c.nA = R1 - R0 + 1; c.kA_m0 = mb + R0 * 64; c.kcol = C_BK + hd * 64; c.vcol = C_BV + hd * 64;
    c.nB = 8; c.strideB = 256; const size_t o = ((size_t)(b * 2 + l) * PAST * 4 + hd) * 64; c.kB = inp(F, I_CNAK) + o; c.vB = inp(F, I_CNAV) + o; c.sc = 1.f;
    attn_item<true>(F, c); }
__device__ __forceinline__ void ph_attn1(Frame& F, int l) {
    relocal(F);
    __syncthreads();
    for (int it = F.vcu; it < 512; it += F.G) na_unit(F, l, it);
    if (F.G < 128) for (int it = F.G - 1 - F.vcu; it < 64; it += F.G) at_ctxB(F, it);
}
__device__ __forceinline__ void ph_attn2(Frame& F, int l) {
    relocal(F);
    __syncthreads();
    for (int it = F.vcu; it < 512; it += F.G) at_gqa(F, l, it);
    for (int it = F.G - 1 - F.vcu; it < 64; it += F.G) at_ctxD(F, l, it);
    if (F.G >= 128) { const int it = F.G - 65 - F.vcu; if (it >= 0 && it < 64) at_ctxB(F, it); }
}


constexpr size_t S5_KC = WS_S5T, S5_WIN = WS_S5T + 1 * MiB, S5_WOUT = WS_S5T + 3 * MiB, S5_L8 = WS_S5T + 5 * MiB;
constexpr int NCHUNK = T / 8;
__device__ __forceinline__ void s5_build_tables(Frame& F, int it4) {
    const int it = it4 >> 2, qq = it4 & 3, l = it >> 4, g = it & 15;
    LAS float* pw = (LAS float*)F.lds;
    LAS float* bb = pw + 2 * 64 * 9 * 2;
    LAS float* cc = bb + 2 * 64 * 16 * 2;
    if (F.tid < 128) { const int d = F.tid >> 6, p = F.tid & 63, ldg = (l * 2 + d) * 16 + g;
        const float dt = expf(inp(F, I_LOGDT)[ldg]); const float are = inp(F, I_ARE)[ldg * 64 + p], aim = inp(F, I_AIM)[ldg * 64 + p];
        float lr = 1.f, li = 0.f;
        for (int e = 0; e <= 8; ++e) { const float mg = expf((float)e * dt * are); float sn, cs; sincosf((float)e * dt * aim, &sn, &cs); pw[((d * 64 + p) * 9 + e) * 2] = mg * cs; pw[((d * 64 + p) * 9 + e) * 2 + 1] = mg * sn; if (e == 1) { lr = mg * cs; li = mg * sn; } }
        const float den = are * are + aim * aim, nr = lr - 1.f, ni = li; const float cr = (nr * are + ni * aim) / den, ci = (ni * are - nr * aim) / den;
        const float* pbr = inp(F, I_BRE) + ((size_t)ldg * 64 + p) * 16; const float* pbi = inp(F, I_BIM) + ((size_t)ldg * 64 + p) * 16;
        const float* pcr = inp(F, I_CRE) + (size_t)ldg * 16 * 64 + p; const float* pci = inp(F, I_CIM) + (size_t)ldg * 16 * 64 + p;
        f32x4 brv[4], biv[4]; float crv[16], civ[16];
#pragma unroll
        for (int j = 0; j < 4; ++j) { brv[j] = *(const f32x4*)(pbr + 4 * j); biv[j] = *(const f32x4*)(pbi + 4 * j); }
#pragma unroll
        for (int j = 0; j < 16; ++j) { crv[j] = pcr[j * 64]; civ[j] = pci[j * 64]; }
#pragma unroll
        for (int j = 0; j < 16; ++j) { const float br = brv[j >> 2][j & 3], bi = biv[j >> 2][j & 3];
            bb[((d * 64 + p) * 16 + j) * 2] = cr * br - ci * bi; bb[((d * 64 + p) * 16 + j) * 2 + 1] = cr * bi + ci * br;
            cc[((d * 16 + j) * 64 + p) * 2] = crv[j]; cc[((d * 16 + j) * 64 + p) * 2 + 1] = civ[j]; }
        float* l8 = (float*)(F.ws + S5_L8) + ((size_t)ldg * 64 + p) * 2; l8[0] = pw[((d * 64 + p) * 9 + 8) * 2]; l8[1] = pw[((d * 64 + p) * 9 + 8) * 2 + 1];
    }
    __syncthreads();
    { bf16* kc = (bf16*)(F.ws + S5_KC) + (size_t)it * 15 * 256; const float* sd = inp(F, I_SSMD) + l * 256 + g * 16;
      for (int idx = qq * 1024 + F.tid; idx < min(15 * 256, qq * 1024 + 1024); idx += NTHR) { const int ti = idx >> 8, i = (idx >> 4) & 15, j = idx & 15, tau = ti - 7; float s = 0.f;
          for (int d = 0; d < 2; ++d) { if ((d == 0 && tau < 0) || (d == 1 && tau > 0)) continue; const int e = tau < 0 ? -tau : tau;
              for (int p = 0; p < 64; ++p) { const float cr = cc[((d * 16 + i) * 64 + p) * 2], ci = cc[((d * 16 + i) * 64 + p) * 2 + 1], wr_ = pw[((d * 64 + p) * 9 + e) * 2], wi = pw[((d * 64 + p) * 9 + e) * 2 + 1];
                  const float br = bb[((d * 64 + p) * 16 + j) * 2], bi = bb[((d * 64 + p) * 16 + j) * 2 + 1];
                  const float xr = cr * wr_ - ci * wi, xi = cr * wi + ci * wr_; s += xr * br - xi * bi; } }
          if (tau == 0 && i == j) s += sd[i];
          kc[idx] = (bf16)f2bf(s); } }
    { const int d = qq >> 1; const int ldg = (l * 2 + d) * 16 + g;
        bf16* win = (bf16*)(F.ws + S5_WIN) + (size_t)ldg * 16384; bf16* wout = (bf16*)(F.ws + S5_WOUT) + (size_t)ldg * 16384;
        for (int idx = (qq & 1) * 8192 + F.tid; idx < (qq & 1) * 8192 + 8192; idx += NTHR) {
            { const int a = idx >> 11, i = (idx >> 7) & 15, p = (idx >> 1) & 63, c = idx & 1, e = d == 0 ? a + 1 : 8 - a;
              const float cr = cc[((d * 16 + i) * 64 + p) * 2], ci = cc[((d * 16 + i) * 64 + p) * 2 + 1], wr_ = pw[((d * 64 + p) * 9 + e) * 2], wi = pw[((d * 64 + p) * 9 + e) * 2 + 1];
              win[idx] = (bf16)f2bf(c == 0 ? cr * wr_ - ci * wi : -(cr * wi + ci * wr_)); }
            { const int p = idx >> 8, c = (idx >> 7) & 1, b = (idx >> 4) & 7, j = idx & 15, e = d == 0 ? 7 - b : b;
              const float wr_ = pw[((d * 64 + p) * 9 + e) * 2], wi = pw[((d * 64 + p) * 9 + e) * 2 + 1], br = bb[((d * 64 + p) * 16 + j) * 2], bi = bb[((d * 64 + p) * 16 + j) * 2 + 1];
              wout[idx] = (bf16)f2bf(c == 0 ? wr_ * br - wi * bi : wr_ * bi + wi * br); }
        } }
    __syncthreads();
}
constexpr int S5_ROW = 272;
__device__ __forceinline__ void ph_s5_s1(Frame& F, int l) {
    relocal(F);
    const int fr = F.lane & 15, q = F.lane >> 4, w = F.wave, dir = w >> 2;
    float* sloc = (float*)(F.ws + WS_XN);
    for (int it = blockIdx.x; it < 256; it += F.G) {
        const int g = it >> 4, cg = it & 15, ldg = (l * 2 + dir) * 16 + g;
        const bf16* wout = (const bf16*)(F.ws + S5_WOUT) + (size_t)ldg * 16384;
        bf16x8 af[2][4];
#pragma unroll
        for (int rt = 0; rt < 2; ++rt)
#pragma unroll
            for (int ks = 0; ks < 4; ++ks) af[rt][ks] = *(const bf16x8*)(wout + (size_t)((w & 3) * 32 + rt * 16 + fr) * 128 + 32 * ks + 8 * q);
        const bf16* cxg = F.CX() + (size_t)g * T * 16;
        v4u pa = (v4u){0u, 0u, 0u, 0u}, pb = pa;
        if (F.tid < 256) { pa = *(const v4u*)(cxg + (size_t)(cg * 18) * 2048 + F.tid * 8); pb = *(const v4u*)(cxg + (size_t)(cg * 18 + 1) * 2048 + F.tid * 8); }
        for (int v = 0; v < 9; ++v) {
            const int ct = cg * 18 + 2 * v; LAS unsigned char* buf = F.lds + (v & 1) * (2 * 4352);
            if (F.tid < 256) { *(LAS v4u*)(buf + (F.tid >> 4) * S5_ROW + (F.tid & 15) * 16) = pa; *(LAS v4u*)(buf + 4352 + (F.tid >> 4) * S5_ROW + (F.tid & 15) * 16) = pb; }
            __syncthreads();
            if (v + 1 < 9 && F.tid < 256) { pa = *(const v4u*)(cxg + (size_t)(ct + 2) * 2048 + F.tid * 8); pb = *(const v4u*)(cxg + (size_t)(ct + 3) * 2048 + F.tid * 8); }
#pragma unroll
            for (int h2 = 0; h2 < 2; ++h2) {
                f32x4 a0 = (f32x4){0.f, 0.f, 0.f, 0.f}, a1 = a0;
#pragma unroll
                for (int ks = 0; ks < 4; ++ks) { const bf16x8 bfr = *(const LAS bf16x8*)(buf + h2 * 4352 + fr * S5_ROW + 64 * ks + 16 * q);
                    a0 = __builtin_amdgcn_mfma_f32_16x16x32_bf16(af[0][ks], bfr, a0, 0, 0, 0); a1 = __builtin_amdgcn_mfma_f32_16x16x32_bf16(af[1][ks], bfr, a1, 0, 0, 0); }
                float* o = sloc + (((size_t)((ct + h2) * 16 + fr) * 2 + dir) * 16 + g) * 128 + (w & 3) * 32 + 4 * q;
                *(f32x4*)o = a0; *(f32x4*)(o + 16) = a1; }
        }
        __syncthreads();
    }
}
__device__ __forceinline__ void ph_s5_scan(Frame& F, int l) {
    relocal(F);
    const float* sloc = (const float*)(F.ws + WS_XN); unsigned* sin = (unsigned*)(F.ws + WS_SIN);
    const int p = F.lane, w = F.wave;
    for (int it = blockIdx.x; it < 256; it += F.G) {
        const int seq = 16 + (it >> 5), d = (it >> 4) & 1, g = it & 15, nb = 512 + (seq - 16) * 512, ldg = (l * 2 + d) * 16 + g;
        const float* l8 = (const float*)(F.ws + S5_L8) + ((size_t)ldg * 64 + p) * 2; const float lr = l8[0], li = l8[1];
        float2 x[64];
#pragma unroll
        for (int k = 0; k < 64; ++k) { const int kk = 64 * w + k, n = nb + (d ? 511 - kk : kk); x[k] = *(const float2*)(sloc + (((size_t)n * 2 + d) * 16 + g) * 128 + 2 * p); }
        float tr = 0.f, ti = 0.f;
#pragma unroll
        for (int k = 0; k < 64; ++k) { const float nr = lr * tr - li * ti + x[k].x, ni = lr * ti + li * tr + x[k].y; tr = nr; ti = ni; }
        LAS float* red = (LAS float*)F.lds;
        __syncthreads();
        red[(w * 64 + p) * 2] = tr; red[(w * 64 + p) * 2 + 1] = ti;
        __syncthreads();
        float ar = lr, ai = li;
#pragma unroll
        for (int q = 0; q < 6; ++q) { const float nr = ar * ar - ai * ai, ni = 2.f * ar * ai; ar = nr; ai = ni; }
        const size_t o = ((((size_t)(seq - 16) * 2 + l) * 2 + d) * 16 + g) * 64 + p; float sr = inp(F, I_SSM0)[o * 2], si = inp(F, I_SSM0)[o * 2 + 1];
        for (int j = 0; j < w; ++j) { const float nr = ar * sr - ai * si + red[(j * 64 + p) * 2], ni = ar * si + ai * sr + red[(j * 64 + p) * 2 + 1]; sr = nr; si = ni; }
        unsigned* so = sin + ((size_t)(d * 16 + g) * NCHUNK) * 64 + p;
#pragma unroll
        for (int k = 0; k < 64; ++k) { const int kk = 64 * w + k, n = nb + (d ? 511 - kk : kk); so[(size_t)n * 64] = pk2(sr, si);
            const float nr = lr * sr - li * si + x[k].x, ni = lr * si + li * sr + x[k].y; sr = nr; si = ni; }
    }
    if (w >= 6) for (int ci = blockIdx.x * 2 + (w - 6); ci < 512; ci += 2 * F.G) {
        const int seq = ci >> 5, d = (ci >> 4) & 1, g = ci & 15, nb = seq * 32, ldg = (l * 2 + d) * 16 + g;
        const float* l8 = (const float*)(F.ws + S5_L8) + ((size_t)ldg * 64 + p) * 2; const float lr = l8[0], li = l8[1];
        float2 x[32];
#pragma unroll
        for (int k = 0; k < 32; ++k) { const int n = nb + (d ? 31 - k : k); x[k] = *(const float2*)(sloc + (((size_t)n * 2 + d) * 16 + g) * 128 + 2 * p); }
        unsigned* so = sin + ((size_t)(d * 16 + g) * NCHUNK) * 64 + p; float sr = 0.f, si = 0.f;
#pragma unroll
        for (int k = 0; k < 32; ++k) { const int n = nb + (d ? 31 - k : k); so[(size_t)n * 64] = pk2(sr, si);
            const float nr = lr * sr - li * si + x[k].x, ni = lr * si + li * sr + x[k].y; sr = nr; si = ni; }
        const size_t o = ((((size_t)seq * 2 + l) * 2 + d) * 16 + g) * 64 + p; F.out[O_SSM + o * 2] = sr; F.out[O_SSM + o * 2 + 1] = si;
    }
}
__device__ __forceinline__ void ph_s5_s3(Frame& F, int l) {
    relocal(F);
    const int fr = F.lane & 15, q = F.lane >> 4, a = F.wave;
    for (int it = blockIdx.x; it < 256; it += F.G) {
        const int g = it >> 4, cg = it & 15, lg = l * 16 + g;
        bf16x8 af[12];
        { const bf16* kc = (const bf16*)(F.ws + S5_KC) + (size_t)lg * 15 * 256;
#pragma unroll
          for (int ks = 0; ks < 4; ++ks) { const int b = 2 * ks + (q >> 1); af[ks] = *(const bf16x8*)(kc + ((a - b + 7) * 16 + fr) * 16 + 8 * (q & 1)); }
#pragma unroll
          for (int d = 0; d < 2; ++d) { const bf16* win = (const bf16*)(F.ws + S5_WIN) + (size_t)((l * 2 + d) * 16 + g) * 16384 + (size_t)(a * 16 + fr) * 128;
#pragma unroll
              for (int ks = 0; ks < 4; ++ks) af[4 + 4 * d + ks] = *(const bf16x8*)(win + 32 * ks + 8 * q); } }
        bf16* cxg = F.CX() + (size_t)g * T * 16;
        const bf16* sf = (const bf16*)(F.ws + WS_SIN) + (size_t)(0 * 16 + g) * NCHUNK * 128; const bf16* sr_ = (const bf16*)(F.ws + WS_SIN) + (size_t)(1 * 16 + g) * NCHUNK * 128;
        v4u pa0, pa1 = (v4u){0u, 0u, 0u, 0u}, pb0, pb1 = (v4u){0u, 0u, 0u, 0u};
#define S3_LOAD(d0, d1, ct) do { const size_t o_ = (size_t)(ct) * 2048 + (F.tid & 255) * 8; d0 = (F.tid < 256) ? *(const v4u*)(cxg + o_) : *(const v4u*)(sf + o_); if (F.tid < 256) d1 = *(const v4u*)(sr_ + o_); } while (0)
        S3_LOAD(pa0, pa1, cg * 18); S3_LOAD(pb0, pb1, cg * 18 + 1);
        for (int v = 0; v < 9; ++v) {
            const int ct = cg * 18 + 2 * v; LAS unsigned char* buf = F.lds + (v & 1) * (6 * 4352);
            { const int e = F.tid & 255, off = (e >> 4) * S5_ROW + (e & 15) * 16;
              *(LAS v4u*)(buf + (F.tid >> 8) * 4352 + off) = pa0; if (F.tid < 256) *(LAS v4u*)(buf + 2 * 4352 + off) = pa1;
              *(LAS v4u*)(buf + 3 * 4352 + (F.tid >> 8) * 4352 + off) = pb0; if (F.tid < 256) *(LAS v4u*)(buf + 5 * 4352 + off) = pb1; }
            __syncthreads();
            if (v + 1 < 9) { S3_LOAD(pa0, pa1, ct + 2); S3_LOAD(pb0, pb1, ct + 3); }
            f32x4 acc = (f32x4){0.f, 0.f, 0.f, 0.f}, acc2 = acc;
#pragma unroll
            for (int ks = 0; ks < 12; ++ks) { const int bo = (ks >> 2) * 4352 + fr * S5_ROW + 64 * (ks & 3) + 16 * q;
                const bf16x8 bfr = *(const LAS bf16x8*)(buf + bo), bfr2 = *(const LAS bf16x8*)(buf + 3 * 4352 + bo);
                acc = __builtin_amdgcn_mfma_f32_16x16x32_bf16(af[ks], bfr, acc, 0, 0, 0); acc2 = __builtin_amdgcn_mfma_f32_16x16x32_bf16(af[ks], bfr2, acc2, 0, 0, 0); }
            v2u o; o.x = pk2(gelu_tanh(acc[0]), gelu_tanh(acc[1])); o.y = pk2(gelu_tanh(acc[2]), gelu_tanh(acc[3]));
            v2u o2; o2.x = pk2(gelu_tanh(acc2[0]), gelu_tanh(acc2[1])); o2.y = pk2(gelu_tanh(acc2[2]), gelu_tanh(acc2[3]));
            if (!F.dry) { *(v2u*)(cxg + ((size_t)(ct * 16 + fr) * 8 + a) * 16 + 4 * q) = o; *(v2u*)(cxg + ((size_t)((ct + 1) * 16 + fr) * 8 + a) * 16 + 4 * q) = o2; }
        }
#undef S3_LOAD
        __syncthreads();
    }
}
__device__ __forceinline__ void ph_glu(Frame& F, int l) {
    relocal(F);
    const int fr = F.lane & 15, q = F.lane >> 4, w = F.wave;
    constexpr int AROW = 528;
    const bf16* wg = (const bf16*)(F.ws + WS_WGLU) + (size_t)l * 65536; const float* bg = inp(F, I_BGLU) + l * 256;
    bf16x8 bfr[2][8];
#pragma unroll
    for (int nt = 0; nt < 2; ++nt)
#pragma unroll
        for (int ks = 0; ks < 8; ++ks) bfr[nt][ks] = *(const bf16x8*)(wg + (size_t)(32 * w + 16 * nt + fr) * 256 + 32 * ks + 8 * q);
    for (int it = blockIdx.x; it < 256; it += F.G) {
        const int m0 = it * 144;
        for (int e = F.tid; e < 144 * 32; e += NTHR) { const int c = e / 144, row = e - c * 144;
            *(LAS v4u*)(F.lds + row * AROW + c * 16) = *(const v4u*)(F.CX() + ((size_t)(c >> 1) * T + m0 + row) * 16 + 8 * (c & 1)); }
        __syncthreads();
        f32x4 acc[9][2]; v2u zq[9][2];
        const f32x4 bq[2] = {*(const f32x4*)(bg + 32 * w + 4 * q), *(const f32x4*)(bg + 32 * w + 16 + 4 * q)};
#pragma unroll
        for (int mt = 0; mt < 9; ++mt) { acc[mt][0] = (f32x4){0.f, 0.f, 0.f, 0.f}; acc[mt][1] = acc[mt][0];
#pragma unroll
            for (int nt = 0; nt < 2; ++nt) zq[mt][nt] = *(const v2u*)(F.PROJ() + (size_t)(m0 + 16 * mt + fr) * PW + C_CZ + 32 * w + 16 * nt + 4 * q); }
#pragma unroll
        for (int mt = 0; mt < 9; ++mt)
#pragma unroll
            for (int ks = 0; ks < 8; ++ks) { const bf16x8 af = *(const LAS bf16x8*)(F.lds + (16 * mt + fr) * AROW + 64 * ks + 16 * q);
                acc[mt][0] = __builtin_amdgcn_mfma_f32_16x16x32_bf16(bfr[0][ks], af, acc[mt][0], 0, 0, 0); acc[mt][1] = __builtin_amdgcn_mfma_f32_16x16x32_bf16(bfr[1][ks], af, acc[mt][1], 0, 0, 0); }
#pragma unroll
        for (int mt = 0; mt < 9; ++mt)
#pragma unroll
            for (int nt = 0; nt < 2; ++nt) { const int row = 16 * mt + fr, c = 32 * w + 16 * nt + 4 * q;
                const v2u yp = *(const LAS v2u*)(F.lds + row * AROW + c * 2); const f32x4 b4 = bq[nt];
                bf16* pz = F.PROJ() + (size_t)(m0 + row) * PW + C_CZ + c; const v2u zz = zq[mt][nt];
                const float y0 = bflo(yp.x), y1 = bfhi(yp.x), y2 = bflo(yp.y), y3 = bfhi(yp.y);
                v2u o; o.x = pk2(y0 * sigm(acc[mt][nt][0] + b4[0]) * silu(bflo(zz.x)), y1 * sigm(acc[mt][nt][1] + b4[1]) * silu(bfhi(zz.x)));
                o.y = pk2(y2 * sigm(acc[mt][nt][2] + b4[2]) * silu(bflo(zz.y)), y3 * sigm(acc[mt][nt][3] + b4[3]) * silu(bfhi(zz.y)));
                if (!F.dry) *(v2u*)pz = o; }
        __syncthreads();
    }
}

__device__ __forceinline__ void ph_gmlp(Frame& F, int l) {
    relocal(F);
    constexpr int VROW = 272;
    const int r = F.lane & 31, h = F.lane >> 5, w = F.wave, g = w >> 1, qh = w & 1;
    LAS unsigned char* VT = F.lds; LAS float* rinv = (LAS float*)(F.lds + 256 * VROW);
    const bf16* wsb = (const bf16*)(F.ws + WS_GMWS) + (size_t)(l * 4 + g) * 16384; const float* gv = inp(F, I_GMVG) + l * 256; const float* gb = inp(F, I_GMB) + (l * 4 + g) * 128;
    bf16* P = F.PROJ();
    bf16x8 wb0[8], wb1[8];
#pragma unroll
    for (int ks = 0; ks < 8; ++ks) { wb0[ks] = *(const bf16x8*)(wsb + (size_t)(qh * 64 + r) * 128 + 16 * ks + 8 * h); wb1[ks] = *(const bf16x8*)(wsb + (size_t)(qh * 64 + 32 + r) * 128 + 16 * ks + 8 * h); }
    for (int ch = blockIdx.x; ch < T / 128; ch += F.G) {
        const int m0 = ch * 128;
        { v2u xr[16];
#pragma unroll
          for (int i = 0; i < 16; ++i) xr[i] = *(const v2u*)(P + (size_t)(m0 + w * 16 + i) * PW + C_AV + F.lane * 4);
#pragma unroll
          for (int i = 0; i < 16; ++i) { const v2u x = xr[i];
            const float a = bflo(x.x), b = bfhi(x.x), c = bflo(x.y), d = bfhi(x.y); const float s = wave_sum(a * a + b * b + c * c + d * d); if (F.lane == 0) rinv[w * 16 + i] = rsqrtf(s * (1.f / 256.f) + EPS); } }
        __syncthreads();
        { const int p = F.tid & 127, sq = F.tid >> 7; const float ri = rinv[p]; const bf16* src = P + (size_t)(m0 + p) * PW + C_AV + sq * 64;
          v4u xq[8]; f32x4 gq0[8], gq1[8];
#pragma unroll
          for (int i = 0; i < 8; ++i) { xq[i] = *(const v4u*)(src + 8 * i); gq0[i] = *(const f32x4*)(gv + sq * 64 + 8 * i); gq1[i] = *(const f32x4*)(gv + sq * 64 + 8 * i + 4); }
#pragma unroll
          for (int i = 0; i < 8; ++i) { const v4u x = xq[i]; const int c0 = sq * 64 + 8 * i; const f32x4 g0 = gq0[i], g1 = gq1[i];
              LAS unsigned short* dst = (LAS unsigned short*)(VT + c0 * VROW + p * 2);
              dst[0 * (VROW / 2)] = (unsigned short)f2bf(bflo(x.x) * ri * g0[0]); dst[1 * (VROW / 2)] = (unsigned short)f2bf(bfhi(x.x) * ri * g0[1]); dst[2 * (VROW / 2)] = (unsigned short)f2bf(bflo(x.y) * ri * g0[2]); dst[3 * (VROW / 2)] = (unsigned short)f2bf(bfhi(x.y) * ri * g0[3]);
              dst[4 * (VROW / 2)] = (unsigned short)f2bf(bflo(x.z) * ri * g1[0]); dst[5 * (VROW / 2)] = (unsigned short)f2bf(bfhi(x.z) * ri * g1[1]); dst[6 * (VROW / 2)] = (unsigned short)f2bf(bflo(x.w) * ri * g1[2]); dst[7 * (VROW / 2)] = (unsigned short)f2bf(bfhi(x.w) * ri * g1[3]); } }
        __syncthreads();
        f32x16 acc[2][2];
#pragma unroll
        for (int i = 0; i < 16; ++i) { acc[0][0][i] = 0.f; acc[0][1][i] = 0.f; acc[1][0][i] = 0.f; acc[1][1][i] = 0.f; }
#pragma unroll
        for (int ks = 0; ks < 8; ++ks) {
            const bf16x8 a0 = *(const LAS bf16x8*)(VT + (g * 64 + r) * VROW + (16 * ks + 8 * h) * 2), a1 = *(const LAS bf16x8*)(VT + (g * 64 + 32 + r) * VROW + (16 * ks + 8 * h) * 2);
            const bf16x8 b0 = wb0[ks], b1 = wb1[ks];
            acc[0][0] = __builtin_amdgcn_mfma_f32_32x32x16_bf16(a0, b0, acc[0][0], 0, 0, 0); acc[0][1] = __builtin_amdgcn_mfma_f32_32x32x16_bf16(a0, b1, acc[0][1], 0, 0, 0);
            acc[1][0] = __builtin_amdgcn_mfma_f32_32x32x16_bf16(a1, b0, acc[1][0], 0, 0, 0); acc[1][1] = __builtin_amdgcn_mfma_f32_32x32x16_bf16(a1, b1, acc[1][1], 0, 0, 0);
        }
        __syncthreads();
        { LAS float* stg = (LAS float*)(F.lds + w * 8704);
#pragma unroll
          for (int qt = 0; qt < 2; ++qt) { const float bias = gb[qh * 64 + 32 * qt + r];
#pragma unroll
            for (int dt = 0; dt < 2; ++dt)
#pragma unroll
                for (int gq = 0; gq < 4; ++gq) *(LAS f32x4*)(stg + r * 68 + 32 * dt + 8 * gq + 4 * h) = (f32x4){acc[dt][qt][4 * gq] + bias, acc[dt][qt][4 * gq + 1] + bias, acc[dt][qt][4 * gq + 2] + bias, acc[dt][qt][4 * gq + 3] + bias};
            LDS_WAIT();
            v4u uq[4], zq[4];
#pragma unroll
            for (int i = 0; i < 4; ++i) { const int tk = i * 8 + (F.lane >> 3), ch = F.lane & 7; const bf16* pr = P + (size_t)(m0 + qh * 64 + 32 * qt + tk) * PW + g * 64 + ch * 8;
                uq[i] = *(const v4u*)(pr + C_AU); zq[i] = *(const v4u*)(pr + C_AZ); }
#pragma unroll
            for (int i = 0; i < 4; ++i) { const int tk = i * 8 + (F.lane >> 3), ch = F.lane & 7; bf16* pr = P + (size_t)(m0 + qh * 64 + 32 * qt + tk) * PW + g * 64 + ch * 8;
                const f32x4 s0 = *(const LAS f32x4*)(stg + tk * 68 + ch * 8), s1 = *(const LAS f32x4*)(stg + tk * 68 + ch * 8 + 4);
                const v4u uu = uq[i], zz = zq[i]; v4u o;
                o.x = pk2(bflo(uu.x) * s0.x * silu(bflo(zz.x)), bfhi(uu.x) * s0.y * silu(bfhi(zz.x))); o.y = pk2(bflo(uu.y) * s0.z * silu(bflo(zz.y)), bfhi(uu.y) * s0.w * silu(bfhi(zz.y)));
                o.z = pk2(bflo(uu.z) * s1.x * silu(bflo(zz.z)), bfhi(uu.z) * s1.y * silu(bfhi(zz.z))); o.w = pk2(bflo(uu.w) * s1.z * silu(bflo(zz.w)), bfhi(uu.w) * s1.w * silu(bfhi(zz.w)));
                if (!F.dry) *(v4u*)(pr + C_AU) = o; }
            LDS_WAIT(); } }
        __syncthreads();
    }
}

#ifndef DUP_CODE
#define DUP_CODE 0
#endif
constexpr int NPH_LAYER = 8, PH_FINAL = 1 + 2 * NPH_LAYER, NPHASES = PH_FINAL + 1;
__global__ void __launch_bounds__(NTHR, 2) fwd_kernel(Args args) {
    extern __shared__ __attribute__((aligned(16))) unsigned char lds_raw[];
    Frame F;
    F.lds = (LAS unsigned char*)lds_raw;
    F.tid = threadIdx.x; F.lane = F.tid & 63; F.wave = __builtin_amdgcn_readfirstlane(F.tid >> 6); F.wave_s = F.wave;
    F.G = gridDim.x; F.gw = blockIdx.x * NWAVES + F.wave; F.NGW = F.G * NWAVES;
    { const int bx = blockIdx.x; F.vcu = (F.G % 8 == 0) ? (bx % 8) * (F.G / 8) + bx / 8 : bx; }
    F.in = args.in; F.out = args.out; F.ws = args.ws;
    for (int u = F.tid; u < (LDS_BYTES - LDSCTL_OFF) / 4; u += NTHR) ((LAS unsigned*)(F.lds + LDSCTL_OFF))[u] = 0u;
    __syncthreads();
    const int lo = args.ph_lo, hi = args.ph_hi;
    F.dry = 0;
    XcdBarrier bar; bar.bar = (unsigned*)(F.ws + WS_CTL) + CW_BAR; bar.x = 0; bar.st = nullptr;
    if (hi - lo > 1) bar = xcd_barrier_post((unsigned*)(F.ws + WS_CTL) + CW_BAR, (volatile LAS unsigned*)(F.lds + MISC_OFF) + 8);
#define IN(k) (lo <= (k) && (k) < hi)
#define SEAM(k) do { if (IN(k) && IN((k) + 1)) xcd_barrier(bar); } while (0)
#if DUP_CODE
#define DUPRUN(code, stmt) do { if (DUP_CODE == (code) && l == 0 && args.dup_code == (code)) { xcd_barrier(bar); F.dry = args.dry_val; stmt; F.dry = 0; } } while (0)
#else
#define DUPRUN(code, stmt) do { } while (0)
#endif
#define GEMM_IN() do { pg8::Gemm g{F.XN(), (const bf16*)(F.ws + WS_WIN) + (size_t)l * NPROJ * D, T, NPROJ, D, D}; pg8::StaticOrder S; S.init(T, NPROJ, F.G, (int)blockIdx.x); \
            EpiIn E{F.PROJ(), F.CX(), F.GSIG()}; pg8::gemm_phase<EpiIn, pg8::StaticOrder>(F.lds, g, S, E, F.wave_s); } while (0)
#define GEMM_OUT() do { pg8::Gemm g{F.XN(), (const bf16*)(F.ws + WS_WOUT) + (size_t)l * D * D, T, D, D, D}; pg8::StaticOrder S; S.init(T, D, F.G, (int)blockIdx.x, 192); \
            if (l == 0) { EpiOut192<0> E{inp(F, I_XP), inp(F, I_XS), (bf16*)F.out, (bf16*)(F.ws + WS_PROJ), F.MOD()}; pg8::gemm_phase<EpiOut192<0>, pg8::StaticOrder, 3>(F.lds, g, S, E, F.wave_s); } \
            else { EpiOut192<1> E{inp(F, I_XP), inp(F, I_XS), (bf16*)F.out, (bf16*)(F.ws + WS_PROJ), F.MOD() + (size_t)9 * 3072}; pg8::gemm_phase<EpiOut192<1>, pg8::StaticOrder, 3>(F.lds, g, S, E, F.wave_s); } } while (0)
    { const int l = 0; if (IN(0)) { ph_prologue(F); DUPRUN(14, ph_prologue(F)); } } SEAM(0);
    for (int l = 0; l < DEPTH; ++l) {
        const int pb = 1 + l * NPH_LAYER;
        if (IN(pb + 0)) { ph_norm(F, l); DUPRUN(1, ph_norm(F, l)); } SEAM(pb + 0);
        if (IN(pb + 1)) { GEMM_IN(); DUPRUN(2, GEMM_IN()); } SEAM(pb + 1);
        if (IN(pb + 2)) { ph_prep(F, l); ph_s5_s1(F, l); ph_attn1(F, l); ph_gmlp(F, l);
            DUPRUN(3, ph_prep(F, l)); DUPRUN(4, ph_s5_s1(F, l)); DUPRUN(5, ph_attn1(F, l)); DUPRUN(6, ph_gmlp(F, l)); } SEAM(pb + 2);
        if (IN(pb + 3)) { ph_s5_scan(F, l); ph_attn2(F, l); DUPRUN(7, ph_s5_scan(F, l)); DUPRUN(8, ph_attn2(F, l)); } SEAM(pb + 3);
        if (IN(pb + 4)) { ph_s5_s3(F, l); DUPRUN(9, ph_s5_s3(F, l)); } SEAM(pb + 4);
        if (IN(pb + 5)) { ph_glu(F, l); DUPRUN(10, ph_glu(F, l)); } SEAM(pb + 5);
        if (IN(pb + 6)) { ph_merge(F, l); DUPRUN(11, ph_merge(F, l)); } SEAM(pb + 6);
        if (IN(pb + 7)) { GEMM_OUT(); DUPRUN(12, GEMM_OUT()); DUPRUN(15, { for (int i_ = 0; i_ < 9; ++i_) xcd_barrier(bar); }); } SEAM(pb + 7);
    }
    if (IN(PH_FINAL)) { ph_final(F); }
#undef IN
#undef SEAM
}

#ifndef DUP_CODE_DEFINED
#endif
#ifndef N_LAUNCH_MODE
#define N_LAUNCH_MODE 1
#endif
extern "C" void kernel_launch(void* const* d_in, const int* in_sizes, int n_in, void* d_out, int out_size, void* d_ws, size_t ws_size, hipStream_t stream) {
    static int grid = 0;
    if (grid == 0) {
        if (n_in != 32 || out_size != (int)O_END || ws_size < WS_END) { fprintf(stderr, "kernel_launch: unexpected shapes: n_in %d out %d ws %zu (need %zu)\n", n_in, out_size, ws_size, (size_t)WS_END); grid = -1; return; }
        int dev = 0, cus = 0, per_cu = 0;
        if (hipGetDevice(&dev) != hipSuccess || hipDeviceGetAttribute(&cus, hipDeviceAttributeMultiprocessorCount, dev) != hipSuccess) { grid = -1; return; }
        if (hipFuncSetAttribute((const void*)fwd_kernel, hipFuncAttributeMaxDynamicSharedMemorySize, LDS_BYTES) != hipSuccess) { fprintf(stderr, "kernel_launch: hipFuncSetAttribute failed\n"); grid = -1; return; }
        if (hipOccupancyMaxActiveBlocksPerMultiprocessor(&per_cu, (const void*)fwd_kernel, NTHR, LDS_BYTES) != hipSuccess || per_cu < 1) { fprintf(stderr, "kernel_launch: occupancy query says %d blocks per CU\n", per_cu); grid = -1; (void)hipGetLastError(); return; }
        grid = cus;
    }
    if (grid < 0) return;
    if (hipMemsetAsync((char*)d_ws + WS_CTL, 0, CTL_ZERO_BYTES, stream) != hipSuccess) return;
    Args a{};
    for (int i = 0; i < 32; ++i) a.in[i] = (const float*)d_in[i];
    a.out = (float*)d_out; a.ws = (unsigned char*)d_ws; a.dup_code = DUP_CODE; a.dry_val = 1;
    if (N_LAUNCH_MODE == 1) { a.ph_lo = 0; a.ph_hi = NPHASES; hipLaunchKernelGGL(fwd_kernel, dim3(grid), dim3(NTHR), LDS_BYTES, stream, a); }
    else for (int p = 0; p < NPHASES; ++p) { a.ph_lo = p; a.ph_hi = p + 1; hipLaunchKernelGGL(fwd_kernel, dim3(grid), dim3(NTHR), LDS_BYTES, stream, a); }
}
```

```cpp
#include <hip/hip_runtime.h>
#include <cstdio>
#include <cstdint>
namespace pg8 {
#define PG8_LAS __attribute__((address_space(3)))
typedef unsigned short bf16_t;
typedef short bf16x8 __attribute__((ext_vector_type(8)));
typedef float f32x4 __attribute__((ext_vector_type(4)));
typedef unsigned u32x4 __attribute__((ext_vector_type(4)));
constexpr int BM = 256, BK = 64, HALF = 128, HTB = HALF * BK * 2  , STAGE_BYTES = 8 * HTB, NXCD = 8, WGM = 8;

__host__ __device__ __forceinline__ int lds_byte(int r, int c) { const int st = (r >> 4) * 2 + (c >> 5), rr = r & 15, cc = c & 31, ob = rr * 64 + cc * 2; return st * 1024 + (ob ^ (((ob >> 9) & 1) << 5)); }
__host__ __device__ __forceinline__ void stage_rc(int b, int& R, int& C) { const int st = b / 1024, sb = b % 1024, swz = sb ^ (((sb >> 9) & 1) << 5); R = (st >> 1) * 16 + swz / 64; C = (st & 1) * 32 + (swz % 64) / 2; }
__host__ __device__ __forceinline__ int perm32(int rho) { const int n = rho >> 4, i = rho & 15; return 8 * (i >> 2) + 4 * n + (i & 3); }

struct Unit { int pm, pn; };
struct Gemm { const bf16_t* A; const bf16_t* Bt; int M, N, K, lda; };


struct StaticOrder {
    int nM, nN, nwg, G, c;
    __host__ __device__ void init(int M, int N, int G_, int c_, int bm = BM) { nM = M / bm; nN = N / BM; nwg = nM * nN; G = G_; c = c_; }
    __host__ __device__ bool next(int i, Unit& u) const {
        const long L = (long)i * G + c; if (L >= nwg) return false;
        int wgid = (int)L; { const int q = nwg / NXCD, r = nwg % NXCD, xcd = wgid % NXCD, off = wgid / NXCD; wgid = (xcd < r ? xcd * (q + 1) : r * (q + 1) + (xcd - r) * q) + off; }
        const int nig = WGM * nN, gid = wgid / nig, fm = gid * WGM, gsz = (nM - fm) < WGM ? (nM - fm) : WGM;
        u.pm = fm + ((wgid % nig) % gsz); u.pn = (wgid % nig) / gsz; return true;
    }
    __device__ __forceinline__ void a_ready(const Unit&) const {}
    __device__ __forceinline__ void done(const Unit&) const {}
};
__device__ __forceinline__ unsigned cvt_pk_bf16(float lo, float hi) { unsigned r; asm volatile("v_cvt_pk_bf16_f32 %0, %1, %2" : "=v"(r) : "v"(lo), "v"(hi)); return r; }

template <class Epi, class Sched, int MR = 4>
__device__ __forceinline__ void gemm_phase(PG8_LAS unsigned char* lds, const Gemm g, const Sched& S, const Epi& E, const int wave_s) {
    unsigned z_ = 0u; asm volatile("" : "+v"(z_)); int tid_ = (wave_s << 6) | (int)__builtin_amdgcn_mbcnt_hi(~0u, __builtin_amdgcn_mbcnt_lo(~0u, z_)); asm volatile("" : "+v"(tid_)); const int tid = tid_, wid = __builtin_amdgcn_readfirstlane(tid >> 6), lane = tid & 63, wr = wid >> 2, wc = wid & 3, fr = lane & 15, fq = lane >> 4;
    const int K = g.K, nt = K / BK;
    unsigned voffA[2], voffB[2];
#pragma unroll
    for (int i = 0; i < 2; ++i) { int R, C; stage_rc(tid * 16 + i * 8192, R, C); const int Rb = Epi::PERM ? ((R & ~31) + perm32(R & 31)) : R;
        voffA[i] = (unsigned)(R * g.lda + C) * 2u; voffB[i] = (unsigned)(Rb * K + C) * 2u; }
    const size_t kstep = (size_t)(BK * 2);
    const size_t hstep = (size_t)HALF * K * 2;
    const size_t tstep = 2 * hstep;
    const size_t hstepA = (size_t)(MR * 32) * g.lda * 2, tstepA = 2 * hstepA;
    const unsigned ldsw = (unsigned)wid * 1024u;
    const int aoff = lds_byte(wr * (MR * 16) + fr, fq * 8), boff = lds_byte(wc * 32 + fr, fq * 8);
#define PG8_SA(b, h) (((b) * 2 + (h)) * HTB)
#define PG8_SB(b, h) ((4 + (b) * 2 + (h)) * HTB)
#define PG8_STAGE(bufoff, gbase, voff) do { _Pragma("unroll") for (int _i = 0; _i < 2; ++_i) \
        __builtin_amdgcn_global_load_lds((const unsigned*)((const char*)(gbase) + (voff)[_i]), (PG8_LAS unsigned*)(lds + (bufoff) + ldsw + _i * 8192), 16, 0, 0); } while (0)
#define PG8_LDA(dst, b, h) do { _Pragma("unroll") for (int m = 0; m < MR; ++m) _Pragma("unroll") for (int k = 0; k < 2; ++k) dst[m][k] = *(const PG8_LAS bf16x8*)(lds + PG8_SA(b, h) + aoff + m * 2048 + k * 1024); } while (0)
#define PG8_LDB(dst, b, h) do { _Pragma("unroll") for (int n = 0; n < 2; ++n) _Pragma("unroll") for (int k = 0; k < 2; ++k) dst[n][k] = *(const PG8_LAS bf16x8*)(lds + PG8_SB(b, h) + boff + n * 2048 + k * 1024); } while (0)
#define PG8_MMA(ai, bj, At, Bt) do { __builtin_amdgcn_s_setprio(1); _Pragma("unroll") for (int m = 0; m < MR; ++m) _Pragma("unroll") for (int n = 0; n < 2; ++n) _Pragma("unroll") for (int k = 0; k < 2; ++k) \
        acc[ai][bj][m][n] = __builtin_amdgcn_mfma_f32_16x16x32_bf16(Bt[n][k], At[m][k], acc[ai][bj][m][n], 0, 0, 0); __builtin_amdgcn_s_setprio(0); } while (0)
#define PG8_WAIT_V(n) asm volatile("s_waitcnt vmcnt(" #n ")" ::: "memory")
#define PG8_WAIT_L(n) asm volatile("s_waitcnt lgkmcnt(" #n ")" ::: "memory")
#define PG8_BAR __builtin_amdgcn_s_barrier()
#define PG8_SCHED __builtin_amdgcn_sched_barrier(0)
    Unit cur, nxt; int ui = 0;
    if (!S.next(0, cur)) return;
    f32x4 acc[2][2][4][2];
#pragma unroll
    for (int a = 0; a < 2; ++a)
#pragma unroll
        for (int b = 0; b < 2; ++b)
#pragma unroll
            for (int m = 0; m < 4; ++m)
#pragma unroll
                for (int n = 0; n < 2; ++n) acc[a][b][m][n] = (f32x4){0.f, 0.f, 0.f, 0.f};
    bf16x8 At[4][2], B0[2][2], B1[2][2];
    const char* cA = (const char*)g.A + (size_t)cur.pm * tstepA; const char* cB = (const char*)g.Bt + (size_t)cur.pn * tstep;
    S.a_ready(cur);
    PG8_STAGE(PG8_SB(0, 0), cB, voffB); PG8_STAGE(PG8_SA(0, 0), cA, voffA); PG8_STAGE(PG8_SB(0, 1), cB + hstep, voffB); PG8_STAGE(PG8_SA(0, 1), cA + hstepA, voffA);
    if (wr == 1) PG8_BAR;
    PG8_WAIT_V(4); PG8_BAR;
    PG8_STAGE(PG8_SB(1, 0), cB + kstep, voffB); PG8_STAGE(PG8_SA(1, 0), cA + kstep, voffA); PG8_STAGE(PG8_SB(1, 1), cB + hstep + kstep, voffB);
    PG8_WAIT_V(6); PG8_BAR;
    for (;;) {
        const bool has_next = S.next(ui + 1, nxt);
        const char* nA = has_next ? (const char*)g.A + (size_t)nxt.pm * tstepA : cA; const char* nB = has_next ? (const char*)g.Bt + (size_t)nxt.pn * tstep : cB;
        for (int t = 0; t < nt; t += 2) {
            const bool last = (t == nt - 2);
            const char* a1 = cA + (size_t)(t + 1) * kstep;
            const char* a2 = last ? nA : cA + (size_t)(t + 2) * kstep; const char* b2 = last ? nB : cB + (size_t)(t + 2) * kstep;
            const char* a3 = a2 + kstep; const char* b3 = b2 + kstep;
            if (last && has_next) S.a_ready(nxt);
            PG8_LDB(B0, 0, 0); PG8_SCHED; PG8_LDA(At, 0, 0); PG8_STAGE(PG8_SA(1, 1), a1 + hstepA, voffA);
            PG8_WAIT_L(8); PG8_BAR; PG8_WAIT_L(0); PG8_MMA(0, 0, At, B0); PG8_BAR; PG8_SCHED;
            PG8_LDB(B1, 0, 1); PG8_STAGE(PG8_SB(0, 0), b2, voffB);
            PG8_BAR; PG8_WAIT_L(0); PG8_MMA(0, 1, At, B1); PG8_BAR;
            PG8_LDA(At, 0, 1); PG8_STAGE(PG8_SA(0, 0), a2, voffA);
            PG8_BAR; PG8_WAIT_L(0); PG8_MMA(1, 0, At, B0); PG8_BAR; PG8_SCHED;
            PG8_STAGE(PG8_SB(0, 1), b2 + hstep, voffB);
            PG8_WAIT_V(6); PG8_BAR; PG8_MMA(1, 1, At, B1); PG8_BAR;
            PG8_LDB(B0, 1, 0); PG8_SCHED; PG8_LDA(At, 1, 0); PG8_STAGE(PG8_SA(0, 1), a2 + hstepA, voffA);
            PG8_WAIT_L(8); PG8_BAR; PG8_WAIT_L(0); PG8_MMA(0, 0, At, B0); PG8_BAR; PG8_SCHED;
            PG8_LDB(B1, 1, 1); PG8_STAGE(PG8_SB(1, 0), b3, voffB);
            PG8_BAR; PG8_WAIT_L(0); PG8_MMA(0, 1, At, B1); PG8_BAR;
            PG8_LDA(At, 1, 1); PG8_STAGE(PG8_SA(1, 0), a3, voffA);
            PG8_BAR; PG8_WAIT_L(0); PG8_MMA(1, 0, At, B0); PG8_BAR; PG8_SCHED;
            PG8_STAGE(PG8_SB(1, 1), b3 + hstep, voffB);
            PG8_WAIT_V(6); PG8_BAR; PG8_MMA(1, 1, At, B1); PG8_BAR;
        }
        if constexpr (!Epi::AFTER_DRAIN) { unsigned z2_ = 0u; asm volatile("" : "+v"(z2_)); const int l2_ = (int)__builtin_amdgcn_mbcnt_hi(~0u, __builtin_amdgcn_mbcnt_lo(~0u, z2_));
            E(acc, cur, wr, wc, l2_ & 15, l2_ >> 4); S.done(cur); }
        if (!has_next) break;
#pragma unroll
        for (int a = 0; a < 2; ++a)
#pragma unroll
            for (int b = 0; b < 2; ++b)
#pragma unroll
                for (int m = 0; m < 4; ++m)
#pragma unroll
                    for (int n = 0; n < 2; ++n) acc[a][b][m][n] = (f32x4){0.f, 0.f, 0.f, 0.f};
        cur = nxt; cA = nA; cB = nB; ++ui;
    }
    PG8_WAIT_V(0);
    if (wr == 0) PG8_BAR;
    PG8_BAR;
    if constexpr (Epi::AFTER_DRAIN) { E.fused(acc, cur, wr, wc, fr, fq, lds, wid, lane); S.done(cur); }
#undef PG8_SA
#undef PG8_SB
#undef PG8_STAGE
#undef PG8_LDA
#undef PG8_LDB
#undef PG8_MMA
#undef PG8_WAIT_V
#undef PG8_WAIT_L
#undef PG8_BAR
#undef PG8_SCHED
}

}

constexpr int NWAVES = 8, NTHR = 512;
constexpr int D = 1024, TCTX = 4096, TLAT = 32768, T = TCTX + TLAT, NPROJ = 7168, PW = 2944;
constexpr int CTX_B = 16, CTX_L = 256, LAT_B = 8, LAT_L = 4096, PAST = 512, DEPTH = 2;
constexpr int C_AU = 0, C_AV = 256, C_AZ = 512, C_BQ = 768, C_BK = 1024, C_BV = 1280, C_BZ = 1536, C_CZ = 1792, C_DQ = 2048, C_DK = 2304, C_DV = 2432, C_DZ = 2560;
constexpr size_t O_Y = 0, O_NAK = 37748736, O_NAV = 39845888, O_GK = 41943040, O_GV = 42991616, O_SSM = 44040192, O_END = 44171264;
constexpr float EPS = 1e-6f;
constexpr size_t MiB = 1u << 20;
constexpr size_t WS_CTL = 0, CTL_ZERO_BYTES = 1 * MiB;
constexpr size_t WS_MOD = 1 * MiB;
constexpr size_t WS_ROPE = 1 * MiB + 256 * 1024;
constexpr size_t WS_KNC = 1 * MiB + 256 * 1024 + 16384;
constexpr size_t WS_GMWS = 1 * MiB + 512 * 1024;
constexpr size_t WS_WGLU = 1 * MiB + 768 * 1024;
constexpr size_t WS_WBR = 2 * MiB;
constexpr size_t WS_WOUT = 6 * MiB;
constexpr size_t WS_WIN = 10 * MiB;
constexpr size_t WS_S5T = 38 * MiB;
constexpr size_t WS_XN = 44 * MiB;
constexpr size_t WS_PROJ = 116 * MiB;
constexpr size_t WS_CX = 324 * MiB;
constexpr size_t WS_GSIG = 342 * MiB;
constexpr size_t WS_SIN = 486 * MiB;
constexpr size_t WS_NAC = 528 * MiB;
constexpr size_t WS_GQC = 576 * MiB;
constexpr size_t WS_END = 640 * MiB;
constexpr int CW_TMO = 0, CW_BAR = 4096;
constexpr int RING_BYTES = 131072, LDSCTL_OFF = 147456, MISC_OFF = LDSCTL_OFF + 320, LDS_BYTES = 151552;

#define GAS __attribute__((address_space(1)))
#define LAS __attribute__((address_space(3)))
typedef unsigned short bf16;
typedef unsigned v4u __attribute__((ext_vector_type(4)));
typedef unsigned v2u __attribute__((ext_vector_type(2)));
typedef float f32x4 __attribute__((ext_vector_type(4)));
typedef short bf16x8 __attribute__((ext_vector_type(8)));
typedef GAS unsigned gu32;
#define RLX_AGENT __ATOMIC_RELAXED, __HIP_MEMORY_SCOPE_AGENT
#define LDS_WAIT() asm volatile("s_waitcnt lgkmcnt(0)" ::: "memory")
#define VM_WAIT() asm volatile("s_waitcnt vmcnt(0)" ::: "memory")
__device__ __forceinline__ unsigned f2bf(float f) { unsigned u = __builtin_bit_cast(unsigned, f); return (u + 0x7fffu + ((u >> 16) & 1u)) >> 16; }
typedef __bf16 hwbf2 __attribute__((ext_vector_type(2)));
typedef float f32x2 __attribute__((ext_vector_type(2)));
__device__ __forceinline__ unsigned pk2(float lo, float hi) { const f32x2 v = {lo, hi}; return __builtin_bit_cast(unsigned, __builtin_convertvector(v, hwbf2)); }
__device__ __forceinline__ float bf2f(bf16 b) { return __builtin_bit_cast(float, (unsigned)b << 16); }
__device__ __forceinline__ float bflo(unsigned w) { return __builtin_bit_cast(float, w << 16); }
__device__ __forceinline__ float bfhi(unsigned w) { return __builtin_bit_cast(float, w & 0xffff0000u); }
template <int O> __device__ __forceinline__ float shx(float v) { return __builtin_bit_cast(float, __builtin_amdgcn_ds_swizzle(__builtin_bit_cast(int, v), (O << 10) | 0x1f)); }
__device__ __forceinline__ float half_sum(float v) { const unsigned b = __builtin_bit_cast(unsigned, v); auto rr = __builtin_amdgcn_permlane32_swap(b, b, false, false); return __builtin_bit_cast(float, (unsigned)rr[0]) + __builtin_bit_cast(float, (unsigned)rr[1]); }
__device__ __forceinline__ float half_max(float v) { const unsigned b = __builtin_bit_cast(unsigned, v); auto rr = __builtin_amdgcn_permlane32_swap(b, b, false, false); return fmaxf(__builtin_bit_cast(float, (unsigned)rr[0]), __builtin_bit_cast(float, (unsigned)rr[1])); }
__device__ __forceinline__ float wave_sum(float v) { v += shx<1>(v); v += shx<2>(v); v += shx<4>(v); v += shx<8>(v); v += shx<16>(v); return half_sum(v); }
__device__ __forceinline__ float wave_max(float v) { v = fmaxf(v, shx<1>(v)); v = fmaxf(v, shx<2>(v)); v = fmaxf(v, shx<4>(v)); v = fmaxf(v, shx<8>(v)); v = fmaxf(v, shx<16>(v)); return half_max(v); }
__device__ __forceinline__ float sigm(float x) { return __builtin_amdgcn_rcpf(1.f + __builtin_amdgcn_exp2f(-1.44269504088896f * x)); }
__device__ __forceinline__ float silu(float x) { return x * sigm(x); }
__device__ __forceinline__ float gelu_tanh(float x) { const float u = 0.7978845608028654f * (x + 0.044715f * x * x * x); return x * sigm(2.f * u); }

#define XB_TMO      128
#define XB_XCNT(j)  (256  + 64 * (j))
#define XB_XSUB(j)  (1280 + 64 * (j))
#define XB_XGEN(j)  (2304 + 64 * (j))
#define XB_TOP      3328
#define XB_TOPGEN   3392
#define XCD_BAR_WORDS 3456
#define XB_SPIN_CAP (1u << 18)

__device__ __forceinline__ unsigned xb_ld(unsigned* p)              { return __hip_atomic_load(p, __ATOMIC_RELAXED, __HIP_MEMORY_SCOPE_AGENT); }
__device__ __forceinline__ unsigned xb_add(unsigned* p, unsigned v) { return __hip_atomic_fetch_add(p, v, __ATOMIC_RELAXED, __HIP_MEMORY_SCOPE_AGENT); }
__device__ __forceinline__ unsigned xb_xcc_id() { return (unsigned)__builtin_amdgcn_s_getreg((3 << 11) | 20) & 0xFu; }
#define XB_SPIN(cond, bar) do { unsigned _sp = 0; while (cond) { __builtin_amdgcn_s_sleep(1); \
    if ((++_sp & 255u) == 0u) { if (xb_ld(&(bar)[XB_TMO])) break; if (_sp > XB_SPIN_CAP) { atomicAdd(&(bar)[XB_TMO], 1u); break; } } } } while (0)

struct XcdBarrier {
    unsigned* bar; unsigned x;
    volatile LAS unsigned* st;
};

__device__ __forceinline__ XcdBarrier xcd_barrier_post(unsigned* bar, volatile LAS unsigned* st) {
    XcdBarrier b; b.bar = bar; b.x = xb_xcc_id(); b.st = st;
    if (threadIdx.x == 0) (void)xb_add(&bar[XB_XCNT(b.x)], 1u);
    return b;
}
__device__ __forceinline__ void xcd_barrier_complete(unsigned* bar, unsigned x, unsigned& nloc, unsigned& nx) {
    const unsigned G = gridDim.x * gridDim.y * gridDim.z;
    unsigned sum, cnt, mine, sp = 0u;
    for (;;) {
        sum = 0u; cnt = 0u; mine = 0u;
#pragma unroll
        for (unsigned j = 0; j < 16; ++j) { const unsigned c = xb_ld(&bar[XB_XCNT(j)]); sum += c; cnt += (c > 0u) ? 1u : 0u; mine = (j == x) ? c : mine; }
        if (sum == G) break;
        __builtin_amdgcn_s_sleep(1);
        if ((++sp & 255u) == 0u) { if (xb_ld(&bar[XB_TMO])) break; if (sp > XB_SPIN_CAP) { atomicAdd(&bar[XB_TMO], 1u); break; } }
    }
    nloc = mine > 0u ? mine : 1u; nx = cnt > 0u ? cnt : 1u;
}

__device__ __forceinline__ void xcd_barrier(const XcdBarrier& b) {
    asm volatile("s_waitcnt vmcnt(0)" ::: "memory");
    __syncthreads();
    if (threadIdx.x == 0) {
        unsigned* bar = b.bar;
        __builtin_amdgcn_s_waitcnt(0);
        unsigned nloc = b.st[0], nx = b.st[1];
        if (nloc == 0u) { xcd_barrier_complete(bar, b.x, nloc, nx); b.st[0] = nloc; b.st[1] = nx; }
        const unsigned old = xb_add(&bar[XB_XSUB(b.x)], 1u);
        const unsigned gen = old / nloc;
        if (old + 1u == (gen + 1u) * nloc) {
            __builtin_amdgcn_fence(__ATOMIC_RELEASE, "agent");
            asm volatile("s_waitcnt vmcnt(0)" ::: "memory");
            const unsigned og = xb_add(&bar[XB_TOP], 1u);
            const unsigned target = (og / nx + 1u) * nx;
            if (og + 1u != target) XB_SPIN(xb_ld(&bar[XB_TOP]) < target, bar);
            xb_add(&bar[XB_XGEN(b.x)], 1u);
            __builtin_amdgcn_fence(__ATOMIC_ACQUIRE, "agent");
            asm volatile("s_waitcnt vmcnt(0)" ::: "memory");
        } else {
            XB_SPIN(xb_ld(&bar[XB_XGEN(b.x)]) == gen, bar);
            __builtin_amdgcn_fence(__ATOMIC_ACQUIRE, "agent");
            asm volatile("s_waitcnt vmcnt(0)" ::: "memory");
        }
    }
    __syncthreads();
}


struct Args { const float* in[32]; float* out; unsigned char* ws; int ph_lo, ph_hi, dup_code, dry_val; };
struct Frame {
    LAS unsigned char* lds;
    int tid, lane, wave, G, gw, NGW, dry, vcu, wave_s;
    const float* const* in; float* out; unsigned char* ws;
    __device__ __forceinline__ bf16* XN() const { return (bf16*)(ws + WS_XN); }
    __device__ __forceinline__ bf16* PROJ() const { return (bf16*)(ws + WS_PROJ); }
    __device__ __forceinline__ bf16* CX() const { return (bf16*)(ws + WS_CX); }
    __device__ __forceinline__ unsigned char* GSIG() const { return ws + WS_GSIG; }
    __device__ __forceinline__ float* MOD() const { return (float*)(ws + WS_MOD); }
    __device__ __forceinline__ float* ROPE() const { return (float*)(ws + WS_ROPE); }
};
enum { I_XP = 0, I_XS, I_C, I_CNAK, I_CNAV, I_CGK, I_CGV, I_SSM0, I_CCTX, I_NORMG, I_WADA, I_BADA, I_WIN, I_GMVG, I_GMWS, I_GMB, I_NABIAS, I_ARE, I_AIM, I_LOGDT,
       I_BRE, I_BIM, I_CRE, I_CIM, I_SSMD, I_WGLU, I_BGLU, I_GQG, I_GKG, I_WBR, I_WOUT, I_FING };
__device__ __forceinline__ const float* inp(const Frame& F, int i) { asm volatile("" : "+s"(i)); return F.in[i]; }
__device__ __forceinline__ int cond_of(int m) { return m < TCTX ? 0 : 1 + ((m - TCTX) >> 12); }
__device__ __forceinline__ const float* xrow(const Frame& F, int l, int m) {
    if (l == 0) return m < TCTX ? inp(F, I_XP) + (size_t)m * D : inp(F, I_XS) + (size_t)(m - TCTX) * D;
    return F.out + (size_t)m * D;
}

__device__ __forceinline__ void relocal(Frame& F) { unsigned z = 0u; asm volatile("" : "+v"(z)); int t = (F.wave_s << 6) | (int)__builtin_amdgcn_mbcnt_hi(~0u, __builtin_amdgcn_mbcnt_lo(~0u, z)); asm volatile("" : "+v"(t));       F.tid = t; F.lane = t & 63; F.wave = __builtin_amdgcn_readfirstlane(t >> 6); F.gw = blockIdx.x * NWAVES + F.wave; }
__device__ __forceinline__ void s5_build_tables(Frame& F, int it);
__device__ __forceinline__ void p0_transpose_item(const float* W, int K, int N, bf16* WT, LAS float* scr, int item, int lane, int nsc0 = 1 << 30, float sc = 1.f) {
    const int nblk = N / 32, kb = item / nblk, nb = item % nblk, k0 = 64 * kb, n0 = 32 * nb; const float wm_ = n0 >= nsc0 ? sc : 1.f;
    { f32x4 v[8];
#pragma unroll
      for (int i = 0; i < 8; ++i) v[i] = *(const f32x4*)(W + (size_t)(k0 + 8 * i + (lane >> 3)) * N + n0 + (lane & 7) * 4);
#pragma unroll
      for (int i = 0; i < 8; ++i) { LAS float* d = scr + (8 * i + (lane >> 3)) * 33 + (lane & 7) * 4; d[0] = v[i].x * wm_; d[1] = v[i].y * wm_; d[2] = v[i].z * wm_; d[3] = v[i].w * wm_; } }
    LDS_WAIT(); asm volatile("" ::: "memory");
    const int c = lane & 7;
#pragma unroll
    for (int j = 0; j < 4; ++j) { const int n = (lane >> 3) + 8 * j; const LAS float* s = scr + (8 * c) * 33 + n;
        v4u o; o.x = pk2(s[0 * 33], s[1 * 33]); o.y = pk2(s[2 * 33], s[3 * 33]); o.z = pk2(s[4 * 33], s[5 * 33]); o.w = pk2(s[6 * 33], s[7 * 33]);
        *(v4u*)(WT + (size_t)(n0 + n) * K + k0 + 8 * c) = o; }
    LDS_WAIT(); asm volatile("" ::: "memory");
}
__device__ __forceinline__ void ph_prologue(Frame& F) {
    relocal(F);
    for (int it = blockIdx.x; it < 128; it += F.G) s5_build_tables(F, it);
    LAS float* scr = (LAS float*)(F.lds + F.wave * 16384);
    constexpr int I_IN = (D / 64) * (NPROJ / 32), I_BR = (256 / 64) * (D / 32), I_OUT = (D / 64) * (D / 32), I_GLU = (256 / 64) * (256 / 32);
    constexpr int NIT = 2 * I_IN + 8 * I_BR + 2 * I_OUT + 2 * I_GLU;
    const bool lastwg = (int)blockIdx.x >= 224; const int nsl_me = (F.G == 256) ? (lastwg ? 3 : 2) : 1, nsl_all = (F.G == 256) ? (224 * 8 * 2 + 32 * 8 * 3) : F.NGW;
    const int sl0 = (F.G == 256) ? (lastwg ? 224 * 8 * 2 + (F.gw - 224 * 8) * 3 : F.gw * 2) : F.gw;
    for (int sj = 0; sj < nsl_me; ++sj)
    for (int it = sl0 + sj; it < NIT; it += nsl_all) {
        int r = it;
        if (r < 2 * I_IN) { const int l = r / I_IN; p0_transpose_item(inp(F, I_WIN) + (size_t)l * D * NPROJ, D, NPROJ, (bf16*)(F.ws + WS_WIN) + (size_t)l * NPROJ * D, scr, r % I_IN, F.lane, 3072, -1.44269504088896f); continue; } r -= 2 * I_IN;
        if (r < 8 * I_BR) { const int q = r / I_BR; p0_transpose_item(inp(F, I_WBR) + (size_t)q * 256 * D, 256, D, (bf16*)(F.ws + WS_WBR) + (size_t)q * D * 256, scr, r % I_BR, F.lane); continue; } r -= 8 * I_BR;
        if (r < 2 * I_OUT) { const int l = r / I_OUT; p0_transpose_item(inp(F, I_WOUT) + (size_t)l * D * D, D, D, (bf16*)(F.ws + WS_WOUT) + (size_t)l * D * D, scr, r % I_OUT, F.lane); continue; } r -= 2 * I_OUT;
        { const int l = r / I_GLU; p0_transpose_item(inp(F, I_WGLU) + (size_t)l * 65536, 256, 256, (bf16*)(F.ws + WS_WGLU) + (size_t)l * 65536, scr, r % I_GLU, F.lane); }
    }
    { const float* src = inp(F, I_GMWS); bf16* dst = (bf16*)(F.ws + WS_GMWS);
      for (int i = blockIdx.x * NTHR + F.tid; i < 2 * 4 * 128 * 128; i += F.G * NTHR) dst[i] = (bf16)f2bf(src[i]); }
    { float* rt = F.ROPE();
      for (int i = (F.G - 1 - (int)blockIdx.x) * NTHR + F.tid; i < 64 * 16; i += F.G * NTHR) { const int pos = i >> 4, k = i & 15;     const float fr = powf(10000.f, -(float)k / 16.f); const float a = (float)pos * fr;
          rt[2 * i] = cosf(a); rt[2 * i + 1] = sinf(a); } }
#pragma unroll
    for (int kvsel = 0; kvsel < 2; ++kvsel) { const float* cb = inp(F, kvsel ? I_CNAV : I_CNAK);
        for (int j = blockIdx.x * NTHR + F.tid; j < 262144; j += F.G * NTHR) { const int l = j >> 17, b = (j >> 14) & 7, rem = j & 16383;
            const float* src = cb + (size_t)(b * 2 + l) * (PAST * 256) + rem * 8;
            const f32x4 a = *(const f32x4*)src, c = *(const f32x4*)(src + 4); v4u o; o.x = pk2(a.x, a.y); o.y = pk2(a.z, a.w); o.z = pk2(c.x, c.y); o.w = pk2(c.z, c.w);
            *(v4u*)((bf16*)(F.ws + WS_NAC) + ((size_t)(l * 8 + b) * PAST + (rem >> 5)) * PW + kvsel * 256 + (rem & 31) * 8) = o; } }
    for (int it = F.G - 1 - (int)blockIdx.x; it < 32; it += F.G) { const int l = it >> 4, b = (it >> 1) & 7, kv = it & 1;
        const float* kp = inp(F, I_CGK) + (((size_t)(b * 2 + l) * PAST + F.tid) * 2 + kv) * 64; float q2 = 0.f;
#pragma unroll
        for (int d = 0; d < 64; d += 4) { const f32x4 v = *(const f32x4*)(kp + d); q2 += (v.x * v.x + v.y * v.y) + (v.z * v.z + v.w * v.w); }
        q2 = wave_max(q2);
        LAS float* red = (LAS float*)(F.lds + 130048);
        __syncthreads();
        if (F.lane == 0) red[F.wave] = q2;
        __syncthreads();
        if (F.tid == 0) { float m = red[0];
#pragma unroll
            for (int w = 1; w < 8; ++w) m = fmaxf(m, red[w]);
            ((float*)(F.ws + WS_KNC))[it] = m; }
    }
    __syncthreads();
    { LAS float* sc = (LAS float*)F.lds;
      LAS float* red = (LAS float*)(F.lds + 9 * 1024 * 4);
      bool loaded = false;
      const int it0 = (F.G >= 224) ? (int)blockIdx.x - 128 : (int)blockIdx.x, itstep = (F.G >= 224) ? 96 : F.G;
      for (int it = it0; it >= 0 && it < 2 * 48; it += itstep) {
          if (!loaded) { const float* pc0 = inp(F, I_CCTX); const float* pc = inp(F, I_C);
              for (int i = F.tid; i < 9 * 1024; i += NTHR) { const int cd = i >> 10, k = i & 1023; const float v = cd == 0 ? pc0[k] : pc[(cd - 1) * 1024 + k]; sc[i] = silu(v); } loaded = true; __syncthreads(); }
          const int l = it / 48, o = (it % 48) * 64 + (F.tid & 63), kg = F.tid >> 6;
          const float* w = inp(F, I_WADA) + (size_t)l * D * 3072 + o;
          float acc[9];
#pragma unroll
          for (int c = 0; c < 9; ++c) acc[c] = 0.f;
          for (int k0 = kg * 128; k0 < kg * 128 + 128; k0 += 16) { float wv[16];
#pragma unroll
              for (int j = 0; j < 16; ++j) wv[j] = w[(size_t)(k0 + j) * 3072];
#pragma unroll
              for (int j = 0; j < 16; ++j)
#pragma unroll
                  for (int c = 0; c < 9; ++c) acc[c] += sc[c * 1024 + k0 + j] * wv[j]; }
#pragma unroll
          for (int c = 0; c < 9; ++c) red[(kg * 9 + c) * 64 + (F.tid & 63)] = acc[c];
          __syncthreads();
          for (int i = F.tid; i < 9 * 64; i += NTHR) { const int c = i >> 6, oo = i & 63; float s = 0.f;
#pragma unroll
              for (int g = 0; g < 8; ++g) s += red[(g * 9 + c) * 64 + oo];
              const int ocol = (it % 48) * 64 + oo; F.MOD()[(size_t)(l * 9 + c) * 3072 + ocol] = s + inp(F, I_BADA)[l * 3072 + ocol]; }
          __syncthreads();
      } }
}

__device__ __forceinline__ void ph_norm(Frame& F, int l) {
    relocal(F);
    const float* ng = inp(F, I_NORMG) + l * D;
    const int RPW = (T + F.NGW - 1) / F.NGW, mbeg = F.gw * RPW, mend = min(T, mbeg + RPW);
    int cd = -1;
    if (l > 0) {
        const bf16* x1 = (const bf16*)F.out;
        f32x4 am[2][2], sh[2][2];
        v4u va[3][2], vb[3][2];
#define NB_LOAD(V, mm0) do { _Pragma("unroll") for (int u = 0; u < 3; ++u) { const int m = (mm0) + u; if (m < mend) { _Pragma("unroll") for (int j = 0; j < 2; ++j) V[u][j] = __builtin_nontemporal_load((const v4u*)(x1 + (size_t)m * D + 512 * j + 8 * F.lane)); } } } while (0)
#define NB_PROC(V, mm0) do { _Pragma("unroll") for (int u = 0; u < 3; ++u) { const int m = (mm0) + u; if (m >= mend) continue; \
                const int c_ = cond_of(m); \
                if (c_ != cd) { cd = c_; const float* md = F.MOD() + (size_t)(l * 9 + cd) * 3072; \
                    _Pragma("unroll") for (int j = 0; j < 2; ++j) _Pragma("unroll") for (int q = 0; q < 2; ++q) { const int c = 512 * j + 8 * F.lane + 4 * q; am[j][q] = *(const f32x4*)(ng + c) * (*(const f32x4*)(md + 1024 + c) + 1.f); sh[j][q] = *(const f32x4*)(md + c); } } \
                float s = 0.f; f32x4 x[2][2]; \
                _Pragma("unroll") for (int j = 0; j < 2; ++j) { const v4u q = V[u][j]; x[j][0] = (f32x4){bflo(q.x), bfhi(q.x), bflo(q.y), bfhi(q.y)}; x[j][1] = (f32x4){bflo(q.z), bfhi(q.z), bflo(q.w), bfhi(q.w)}; \
                    s += (x[j][0].x * x[j][0].x + x[j][0].y * x[j][0].y) + (x[j][0].z * x[j][0].z + x[j][0].w * x[j][0].w) + (x[j][1].x * x[j][1].x + x[j][1].y * x[j][1].y) + (x[j][1].z * x[j][1].z + x[j][1].w * x[j][1].w); } \
                const float r = rsqrtf(wave_sum(s) * (1.f / D) + EPS); \
                bf16* orow = F.XN() + (size_t)m * D; \
                _Pragma("unroll") for (int j = 0; j < 2; ++j) { const f32x4 h0 = x[j][0] * r * am[j][0] + sh[j][0], h1 = x[j][1] * r * am[j][1] + sh[j][1]; \
                    v4u o; o.x = pk2(h0.x, h0.y); o.y = pk2(h0.z, h0.w); o.z = pk2(h1.x, h1.y); o.w = pk2(h1.z, h1.w); *(v4u*)(orow + 512 * j + 8 * F.lane) = o; } } } while (0)
        NB_LOAD(va, mbeg);
        for (int m0 = mbeg; m0 < mend; m0 += 6) { NB_LOAD(vb, m0 + 3); NB_PROC(va, m0); NB_LOAD(va, m0 + 6); NB_PROC(vb, m0 + 3); }
#undef NB_LOAD
#undef NB_PROC
        return;
    }
    f32x4 am[4], sh[4];
    f32x4 va[3][4], vb[3][4];
#define NF_LOAD(V, mm0) do { _Pragma("unroll") for (int u = 0; u < 3; ++u) { const int m = (mm0) + u; if (m < mend) { const float* xr = xrow(F, l, m); _Pragma("unroll") for (int j = 0; j < 4; ++j) V[u][j] = __builtin_nontemporal_load((const f32x4*)(xr + 256 * j + 4 * F.lane)); } } } while (0)
#define NF_PROC(V, mm0) do { _Pragma("unroll") for (int u = 0; u < 3; ++u) { const int m = (mm0) + u; if (m >= mend) continue; \
            const int c_ = cond_of(m); \
            if (c_ != cd) { cd = c_; const float* md = F.MOD() + (size_t)(l * 9 + cd) * 3072; \
                _Pragma("unroll") for (int j = 0; j < 4; ++j) { const int c = 256 * j + 4 * F.lane; am[j] = *(const f32x4*)(ng + c) * (*(const f32x4*)(md + 1024 + c) + 1.f); sh[j] = *(const f32x4*)(md + c); } } \
            float s = 0.f; \
            _Pragma("unroll") for (int j = 0; j < 4; ++j) s += (V[u][j].x * V[u][j].x + V[u][j].y * V[u][j].y) + (V[u][j].z * V[u][j].z + V[u][j].w * V[u][j].w); \
            const float r = rsqrtf(wave_sum(s) * (1.f / D) + EPS); \
            bf16* orow = F.XN() + (size_t)m * D; \
            _Pragma("unroll") for (int j = 0; j < 4; ++j) { const f32x4 h = V[u][j] * r * am[j] + sh[j]; v2u o; o.x = pk2(h.x, h.y); o.y = pk2(h.z, h.w); *(v2u*)(orow + 256 * j + 4 * F.lane) = o; } } } while (0)
    NF_LOAD(va, mbeg);
    for (int m0 = mbeg; m0 < mend; m0 += 6) { NF_LOAD(vb, m0 + 3); NF_PROC(va, m0); NF_LOAD(va, m0 + 6); NF_PROC(vb, m0 + 3); }
#undef NF_LOAD
#undef NF_PROC
}
__device__ __forceinline__ void ph_final(Frame& F) {
    relocal(F);
    const float* ng = inp(F, I_FING);
    f32x4 g4[2][2];
#pragma unroll
    for (int j = 0; j < 2; ++j) { g4[j][0] = *(const f32x4*)(ng + 512 * j + 8 * F.lane); g4[j][1] = *(const f32x4*)(ng + 512 * j + 8 * F.lane + 4); }
    const bf16* x2 = (const bf16*)(F.ws + WS_PROJ);
    const int RPW = (T + F.NGW - 1) / F.NGW, mbeg = F.gw * RPW, mend = min(T, mbeg + RPW);
    v4u va[3][2], vb[3][2];
#define FN_LOAD(V, mm0) do { _Pragma("unroll") for (int u = 0; u < 3; ++u) { const int m = (mm0) + u; if (m < mend) { _Pragma("unroll") for (int j = 0; j < 2; ++j) V[u][j] = __builtin_nontemporal_load((const v4u*)(x2 + (size_t)m * D + 512 * j + 8 * F.lane)); } } } while (0)
#define FN_PROC(V, mm0) do { _Pragma("unroll") for (int u = 0; u < 3; ++u) { const int m = (mm0) + u; if (m >= mend) continue; \
            float* yr = F.out + (size_t)m * D; float s = 0.f; f32x4 x[2][2]; \
            _Pragma("unroll") for (int j = 0; j < 2; ++j) { const v4u q = V[u][j]; x[j][0] = (f32x4){bflo(q.x), bfhi(q.x), bflo(q.y), bfhi(q.y)}; x[j][1] = (f32x4){bflo(q.z), bfhi(q.z), bflo(q.w), bfhi(q.w)}; \
                s += (x[j][0].x * x[j][0].x + x[j][0].y * x[j][0].y) + (x[j][0].z * x[j][0].z + x[j][0].w * x[j][0].w) + (x[j][1].x * x[j][1].x + x[j][1].y * x[j][1].y) + (x[j][1].z * x[j][1].z + x[j][1].w * x[j][1].w); } \
            const float r = rsqrtf(wave_sum(s) * (1.f / D) + EPS); \
            _Pragma("unroll") for (int j = 0; j < 2; ++j) { *(f32x4*)(yr + 512 * j + 8 * F.lane) = x[j][0] * r * g4[j][0]; *(f32x4*)(yr + 512 * j + 8 * F.lane + 4) = x[j][1] * r * g4[j][1]; } } } while (0)
    FN_LOAD(va, mbeg);
    for (int m0 = mbeg; m0 < mend; m0 += 6) { FN_LOAD(vb, m0 + 3); FN_PROC(va, m0); FN_LOAD(va, m0 + 6); FN_PROC(vb, m0 + 3); }
#undef FN_LOAD
#undef FN_PROC
}

struct EpiIn {
    static constexpr bool PERM = true, AFTER_DRAIN = false;
    bf16* proj; bf16* cx; unsigned char* gsig;
    __device__ __forceinline__ void operator()(const f32x4 (&acc)[2][2][4][2], const pg8::Unit& u, int wr, int wc, int fr, int fq) const {
        const int row0 = u.pm * 256 + wr * 64 + fr, cw = wc * 32 + 8 * fq;
        if (u.pn < 12) {
            const int pc0 = (u.pn < 7 ? u.pn : u.pn - 1) * 256;
            const float qs = (u.pn == 3) ? 0.125f * 1.44269504088896f : 1.f;
#pragma unroll
            for (int ai = 0; ai < 2; ++ai)
#pragma unroll
                for (int m = 0; m < 4; ++m) { const int row = row0 + ai * 128 + m * 16;
#pragma unroll
                    for (int bj = 0; bj < 2; ++bj) { const int c = cw + bj * 128; const f32x4 v0 = acc[ai][bj][m][0] * qs, v1 = acc[ai][bj][m][1] * qs;
                        v4u w; w.x = pg8::cvt_pk_bf16(v0[0], v0[1]); w.y = pg8::cvt_pk_bf16(v0[2], v0[3]); w.z = pg8::cvt_pk_bf16(v1[0], v1[1]); w.w = pg8::cvt_pk_bf16(v1[2], v1[3]);
                        bf16* dst = (u.pn == 7) ? cx + ((size_t)(c >> 4) * T + row) * 16 + (c & 8) : proj + (size_t)row * PW + pc0 + c;
                        *(v4u*)dst = w; } }
        } else {
            const int pg = u.pn - 12;
            unsigned char* gblk = gsig + ((size_t)((u.pm * 4 + (pg >> 2)) * 8 + (pg & 3) * 2)) * 32768 + ((wr * 2 + (wc >> 1)) * 4) * 1024 + (fq * 16 + fr) * 16 + (wc & 1) * 8;
#pragma unroll
            for (int ai = 0; ai < 2; ++ai)
#pragma unroll
                for (int m = 0; m < 4; ++m) { const int row = row0 + ai * 128 + m * 16;
#pragma unroll
                    for (int bj = 0; bj < 2; ++bj) { const int c = cw + bj * 128; const f32x4 v0 = acc[ai][bj][m][0], v1 = acc[ai][bj][m][1];
                        v2u w; w.x = 0u; w.y = 0u; const float k = 1.f / 255.f;
#pragma unroll
                        for (int j = 0; j < 4; ++j) { w.x = __builtin_amdgcn_cvt_pk_u8_f32(__builtin_amdgcn_rcpf(__builtin_fmaf(__builtin_amdgcn_exp2f(v0[j]), k, k)), j, w.x);
                            w.y = __builtin_amdgcn_cvt_pk_u8_f32(__builtin_amdgcn_rcpf(__builtin_fmaf(__builtin_amdgcn_exp2f(v1[j]), k, k)), j, w.y); }
                        __builtin_nontemporal_store(w, (v2u*)(gblk + (size_t)bj * 32768 + (ai * 16 + m) * 1024)); } }
        }
    }
};
struct EpiOut {
    static constexpr bool PERM = true, AFTER_DRAIN = false;
    const float* xp; const float* xs; bf16* x1; float* x2; const float* mod; int l;
    __device__ __forceinline__ void operator()(const f32x4 (&acc)[2][2][4][2], const pg8::Unit& u, int wr, int wc, int fr, int fq) const {
        const int row0 = u.pm * 256 + wr * 64 + fr, col0 = u.pn * 256 + wc * 32 + 8 * fq;
        const int cd = u.pm < 16 ? 0 : 1 + ((u.pm - 16) >> 4);
        const float* gate = mod + (size_t)cd * 3072 + 2048;
        f32x4 gv[2][2];
#pragma unroll
        for (int bj = 0; bj < 2; ++bj)
#pragma unroll
            for (int n = 0; n < 2; ++n) gv[bj][n] = *(const f32x4*)(gate + col0 + bj * 128 + n * 4);
        if (l == 0) {
            const float* xb = u.pm < 16 ? xp : xs - (size_t)TCTX * D;
#pragma unroll
            for (int ai = 0; ai < 2; ++ai)
#pragma unroll
                for (int mh = 0; mh < 2; ++mh) {
                    f32x4 xo[2][2][2];
#pragma unroll
                    for (int mm = 0; mm < 2; ++mm) { const size_t off = (size_t)(row0 + ai * 128 + (2 * mh + mm) * 16) * D + col0;
#pragma unroll
                        for (int bj = 0; bj < 2; ++bj)
#pragma unroll
                            for (int n = 0; n < 2; ++n) xo[mm][bj][n] = *(const f32x4*)(xb + off + bj * 128 + n * 4); }
#pragma unroll
                    for (int mm = 0; mm < 2; ++mm) { const size_t off = (size_t)(row0 + ai * 128 + (2 * mh + mm) * 16) * D + col0;
#pragma unroll
                        for (int bj = 0; bj < 2; ++bj) { const f32x4 r0 = xo[mm][bj][0] + gv[bj][0] * acc[ai][bj][2 * mh + mm][0], r1 = xo[mm][bj][1] + gv[bj][1] * acc[ai][bj][2 * mh + mm][1];
                            v4u w; w.x = pk2(r0.x, r0.y); w.y = pk2(r0.z, r0.w); w.z = pk2(r1.x, r1.y); w.w = pk2(r1.z, r1.w); *(v4u*)(x1 + off + bj * 128) = w; } }
                    asm volatile("" ::: "memory"); }
        } else {
#pragma unroll
            for (int ai = 0; ai < 2; ++ai) {
                v4u xo[4][2];
#pragma unroll
                for (int m = 0; m < 4; ++m) { const size_t off = (size_t)(row0 + ai * 128 + m * 16) * D + col0;
#pragma unroll
                    for (int bj = 0; bj < 2; ++bj) xo[m][bj] = *(const v4u*)(x1 + off + bj * 128); }
#pragma unroll
                for (int m = 0; m < 4; ++m) { const size_t off = (size_t)(row0 + ai * 128 + m * 16) * D + col0;
#pragma unroll
                    for (int bj = 0; bj < 2; ++bj) { const v4u q = xo[m][bj];
                        const f32x4 a0 = {bflo(q.x), bfhi(q.x), bflo(q.y), bfhi(q.y)}, a1 = {bflo(q.z), bfhi(q.z), bflo(q.w), bfhi(q.w)};
                        *(f32x4*)(x2 + off + bj * 128) = a0 + gv[bj][0] * acc[ai][bj][m][0]; *(f32x4*)(x2 + off + bj * 128 + 4) = a1 + gv[bj][1] * acc[ai][bj][m][1]; } }
                asm volatile("" ::: "memory"); }
        }
    }
};


template <int l>
struct EpiOut192 {
    static constexpr bool PERM = true, AFTER_DRAIN = false;
    const float* xp; const float* xs; bf16* x1; bf16* x2; const float* mod;
    __device__ __forceinline__ void operator()(const f32x4 (&acc)[2][2][4][2], const pg8::Unit& u, int wr, int wc, int fr, int fq) const {
        const int rb = u.pm * 192 + wr * 48, col0 = u.pn * 256 + wc * 32 + 8 * fq;
        const int cd0 = u.pm * 192 < TCTX ? 0 : 1 + ((u.pm * 192 - TCTX) >> 12), cd1 = u.pm * 192 + 191 < TCTX ? 0 : 1 + ((u.pm * 192 + 191 - TCTX) >> 12); const bool same = cd0 == cd1;
        f32x4 gu[2][2];
#pragma unroll
        for (int bj = 0; bj < 2; ++bj) { gu[bj][0] = *(const f32x4*)(mod + (size_t)cd0 * 3072 + 2048 + col0 + bj * 128); gu[bj][1] = *(const f32x4*)(mod + (size_t)cd0 * 3072 + 2048 + col0 + bj * 128 + 4); }
        f32x4 xo[l == 0 ? 2 : 1][3][2][2]; v4u xh[l == 0 ? 1 : 2][3][2];
#pragma unroll
        for (int ai = 0; ai < 2; ++ai)
#pragma unroll
            for (int m = 0; m < 3; ++m) { const int rblk = rb + ai * 96 + m * 16; const size_t off = (size_t)(rblk + fr) * D + col0;
                if (l == 0) { const float* xb = rblk < TCTX ? xp : xs - (size_t)TCTX * D;
#pragma unroll
                    for (int bj = 0; bj < 2; ++bj) { xo[l == 0 ? ai : 0][m][bj][0] = __builtin_nontemporal_load((const f32x4*)(xb + off + bj * 128)); xo[l == 0 ? ai : 0][m][bj][1] = __builtin_nontemporal_load((const f32x4*)(xb + off + bj * 128 + 4)); } }
                else {
#pragma unroll
                    for (int bj = 0; bj < 2; ++bj) xh[l == 0 ? 0 : ai][m][bj] = __builtin_nontemporal_load((const v4u*)(x1 + off + bj * 128)); } }
#pragma unroll
        for (int ai = 0; ai < 2; ++ai) {
#pragma unroll
            for (int m = 0; m < 3; ++m) { const int rblk = rb + ai * 96 + m * 16; const size_t off = (size_t)(rblk + fr) * D + col0;
                const float* gate = mod + (size_t)(rblk < TCTX ? 0 : 1 + ((rblk - TCTX) >> 12)) * 3072 + 2048;
#pragma unroll
                for (int bj = 0; bj < 2; ++bj) { f32x4 g0 = gu[bj][0], g1 = gu[bj][1];
                    if (!same) { g0 = *(const f32x4*)(gate + col0 + bj * 128); g1 = *(const f32x4*)(gate + col0 + bj * 128 + 4); }
                    if (l == 0) { const f32x4 r0 = xo[l == 0 ? ai : 0][m][bj][0] + g0 * acc[ai][bj][m][0], r1 = xo[l == 0 ? ai : 0][m][bj][1] + g1 * acc[ai][bj][m][1];
                        v4u w; w.x = pk2(r0.x, r0.y); w.y = pk2(r0.z, r0.w); w.z = pk2(r1.x, r1.y); w.w = pk2(r1.z, r1.w); *(v4u*)(x1 + off + bj * 128) = w; }
                    else { const v4u q = xh[l == 0 ? 0 : ai][m][bj]; const f32x4 a0 = {bflo(q.x), bfhi(q.x), bflo(q.y), bfhi(q.y)}, a1 = {bflo(q.z), bfhi(q.z), bflo(q.w), bfhi(q.w)};
                        const f32x4 r0 = a0 + g0 * acc[ai][bj][m][0], r1 = a1 + g1 * acc[ai][bj][m][1];
                        v4u w; w.x = pk2(r0.x, r0.y); w.y = pk2(r0.z, r0.w); w.z = pk2(r1.x, r1.y); w.w = pk2(r1.z, r1.w); *(v4u*)(x2 + off + bj * 128) = w; } } }
            asm volatile("" ::: "memory"); }
    }
};

__device__ __forceinline__ int ycol_of(int n) { return ((0x8730 >> (4 * n)) & 15) * 256; }
__device__ __forceinline__ int mg_off(int row, int chunk) { return row * 128 + ((chunk ^ ((row >> 1) & 7)) << 4); }
__device__ __forceinline__ void ph_merge(Frame& F, int l) {
    relocal(F);
    const int wm = F.wave >> 1, wn = F.wave & 1, fr = F.lane & 15, fq = F.lane >> 4;
    LAS unsigned char* lds = F.lds;
    constexpr int ABYTES = 256 * 128, BBYTES = 128 * 128, STG = ABYTES + BBYTES;
    const bf16* Yb = F.PROJ(); const bf16* WB = (const bf16*)(F.ws + WS_WBR) + (size_t)l * 4 * D * 256; const unsigned char* gs = F.GSIG(); bf16* outp = F.XN();
    const int lr = F.lane >> 3, lc = F.lane & 7;
    unsigned voffA[4], voffB[2];
#pragma unroll
    for (int i = 0; i < 4; ++i) { const int rr = (F.wave * 4 + i) * 8 + lr, gc = lc ^ ((rr >> 1) & 7); voffA[i] = (unsigned)(rr * PW + gc * 8) * 2u; }
#pragma unroll
    for (int i = 0; i < 2; ++i) { const int rr = (F.wave * 2 + i) * 8 + lr, gc = lc ^ ((rr >> 1) & 7), wrow = (rr & ~31) + pg8::perm32(rr & 31); voffB[i] = (unsigned)(wrow * 256 + gc * 8) * 2u; }
    constexpr int NU = 144 * 8;
    if (F.vcu >= NU) return;
    const bool halfmode = F.G == 256; const int nu = halfmode ? 5 : (NU - 1 - F.vcu) / F.G + 1, ngs = nu * 16;
    const int hpm = 128 + (F.vcu >> 4), hpn = (F.vcu >> 1) & 7, hrow = (F.vcu & 1) * 128;
#define MG_STAGE(gsx, bufi) do { const int g_ = (gsx) < ngs ? (gsx) : ngs - 1; const int it_ = F.vcu + (g_ >> 4) * F.G, s_ = g_ & 15, n_ = s_ >> 2, k0_ = (s_ & 3) * 64; \
            const bool hu_ = halfmode && (g_ >> 4) == 4; const int r0_ = hu_ ? hpm * 256 + hrow : (it_ >> 3) * 256, c0_ = hu_ ? hpn * 128 : (it_ & 7) * 128;        \
            LAS unsigned char* b_ = lds + (bufi) * STG; \
            const char* ya_ = (const char*)(Yb + (size_t)r0_ * PW + ycol_of(n_) + k0_); const char* wb_ = (const char*)(WB + ((size_t)n_ * D + c0_) * 256 + k0_); \
            _Pragma("unroll") for (int i_ = 0; i_ < 4; ++i_) __builtin_amdgcn_global_load_lds((const unsigned*)(ya_ + voffA[i_]), (LAS unsigned*)(b_ + (F.wave * 4 + i_) * 1024), 16, 0, 0); \
            _Pragma("unroll") for (int i_ = 0; i_ < 2; ++i_) __builtin_amdgcn_global_load_lds((const unsigned*)(wb_ + voffB[i_]), (LAS unsigned*)(b_ + ABYTES + (F.wave * 2 + i_) * 1024), 16, 0, 0); } while (0)
#define MG_WAIT(N) do { asm volatile("" ::: "memory"); __builtin_amdgcn_s_waitcnt(((N) & 15) | (7 << 4) | (((N) >> 4) << 14)); __builtin_amdgcn_s_barrier(); asm volatile("" ::: "memory"); } while (0)
    MG_STAGE(0, 0); MG_STAGE(1, 1); MG_STAGE(2, 2);
    MG_WAIT(12);
    int bcur = 0;
    bf16x8 af0[4], af1[4], bfx[4];
#define MG_FRAG_A(AF, buf, kh, RB) do { const LAS unsigned char* ab_ = lds + (buf) * STG; \
        _Pragma("unroll") for (int mi_ = 0; mi_ < 4; ++mi_) AF[mi_] = *(const LAS bf16x8*)(ab_ + mg_off((RB) + mi_ * 16 + fr, (kh) * 4 + fq)); } while (0)
#define MG_FRAG_B(BF, buf, kh) do { const LAS unsigned char* bb_ = lds + (buf) * STG + ABYTES; \
        _Pragma("unroll") for (int ni_ = 0; ni_ < 4; ++ni_) BF[ni_] = *(const LAS bf16x8*)(bb_ + mg_off(wn * 64 + ni_ * 16 + fr, (kh) * 4 + fq)); } while (0)
#define MG_MMA(AF, BF) do { __builtin_amdgcn_s_setprio(1); _Pragma("unroll") for (int mi_ = 0; mi_ < 4; ++mi_) { if (mi_ < nmi) { _Pragma("unroll") for (int ni_ = 0; ni_ < 4; ++ni_) acc[mi_][ni_] = __builtin_amdgcn_mfma_f32_16x16x32_bf16(BF[ni_], AF[mi_], acc[mi_][ni_], 0, 0, 0); } } __builtin_amdgcn_s_setprio(0); } while (0)
    MG_FRAG_A(af0, 0, 0, wm * 64);
    for (int u = 0; u < nu; ++u) {
        const bool hu = halfmode && u == 4, hun = halfmode && u == 3;
        const int it = F.vcu + u * F.G, pm = hu ? hpm : it >> 3, pn = hu ? hpn : it & 7, r0 = pm * 256 + (hu ? hrow : 0), c0 = pn * 128;
        const int nmi = hu ? 2 : 4, rb = hu ? wm * 32 : wm * 64, rbn = hun ? wm * 32 : wm * 64;
        f32x4 acc[4][4], tot[4][4];
#pragma unroll
        for (int i = 0; i < 4; ++i)
#pragma unroll
            for (int j = 0; j < 4; ++j) { acc[i][j] = (f32x4){0.f, 0.f, 0.f, 0.f}; tot[i][j] = (f32x4){0.f, 0.f, 0.f, 0.f}; }
        const unsigned char* gblk = gs + ((size_t)(pm * 4) * 8 + pn) * 32768 + (size_t)wn * 4096 + F.lane * 16; const int grow = (hu ? hrow : 0) + rb;
        for (int n = 0; n < 4; ++n) {
            v4u gq[4];
#pragma unroll
            for (int k4 = 0; k4 < 4; ++k4) { const int gsx = u * 16 + n * 4 + k4;
                MG_FRAG_B(bfx, bcur, 0); MG_FRAG_A(af1, bcur, 1, rb);
                __builtin_amdgcn_sched_barrier(0);
                MG_MMA(af0, bfx);
                MG_FRAG_B(bfx, bcur, 1);
                __builtin_amdgcn_sched_barrier(0);
                if (k4 == 0) { if (u > 0 && n == 0) MG_WAIT(14); else MG_WAIT(6); }
                else if (k4 == 1) { if (hu) { if (n == 0) MG_WAIT(16); else MG_WAIT(8); } else { if (u > 0 && n == 0) MG_WAIT(18); else MG_WAIT(10); } }
                else if (k4 == 2) { if (hu) MG_WAIT(8); else MG_WAIT(10); }
                else MG_WAIT(6);
                MG_STAGE(gsx + 3, bcur);
                if (k4 == 0) {
#pragma unroll
                    for (int mi = 0; mi < 4; ++mi) if (mi < nmi) { const int R = grow + 16 * mi; gq[mi] = __builtin_nontemporal_load((const v4u*)(gblk + (size_t)n * (8 * 32768) + (size_t)(((R >> 6) * 2) * 4 + ((R >> 4) & 3)) * 1024)); } }
                bcur = bcur == 2 ? 0 : bcur + 1;
                MG_FRAG_A(af0, bcur, 0, (k4 == 3 && n == 3) ? rbn : rb);
                __builtin_amdgcn_sched_barrier(0);
                MG_MMA(af1, bfx);
                __builtin_amdgcn_sched_barrier(0);
                if (k4 == 3) {
#pragma unroll
                    for (int mi = 0; mi < 4; ++mi) if (mi < nmi) {
#pragma unroll
                        for (int ni = 0; ni < 4; ++ni) { const unsigned q = gq[mi][ni];
                            f32x4 g; g.x = (float)(q & 255u); g.y = (float)((q >> 8) & 255u); g.z = (float)((q >> 16) & 255u); g.w = (float)(q >> 24);
                            tot[mi][ni] += g * acc[mi][ni]; acc[mi][ni] = (f32x4){0.f, 0.f, 0.f, 0.f}; } }
                }
            }
        }
#pragma unroll
        for (int mi = 0; mi < 4; ++mi) if (mi < nmi)
#pragma unroll
            for (int p = 0; p < 2; ++p) { const float k255 = 1.f / 255.f; const f32x4 t0 = tot[mi][2 * p] * k255, t1 = tot[mi][2 * p + 1] * k255; v4u o; o.x = pk2(t0.x, t0.y); o.y = pk2(t0.z, t0.w); o.z = pk2(t1.x, t1.y); o.w = pk2(t1.z, t1.w);
                *(v4u*)(outp + (size_t)(r0 + rb + mi * 16 + fr) * D + c0 + wn * 64 + 32 * p + 8 * fq) = o; }
    }
    MG_WAIT(0);
#undef MG_STAGE
#undef MG_WAIT
#undef MG_FRAG_A
#undef MG_FRAG_B
#undef MG_MMA
}


constexpr float AT_C = 0.125f * 1.44269504088896f;
__device__ __forceinline__ void ph_prep(Frame& F, int l) {
    relocal(F);
    const float* rope = F.ROPE();
    const int j = F.lane & 7, ug = F.lane >> 3;
    float gq8[8], gk8[8];
    { const f32x4* pq = (const f32x4*)(inp(F, I_GQG) + l * 64 + 8 * j); const f32x4* pk = (const f32x4*)(inp(F, I_GKG) + l * 64 + 8 * j); const f32x4 q0 = pq[0], q1 = pq[1], k0 = pk[0], k1 = pk[1];
      gq8[0] = q0.x; gq8[1] = q0.y; gq8[2] = q0.z; gq8[3] = q0.w; gq8[4] = q1.x; gq8[5] = q1.y; gq8[6] = q1.z; gq8[7] = q1.w; gk8[0] = k0.x; gk8[1] = k0.y; gk8[2] = k0.z; gk8[3] = k0.w; gk8[4] = k1.x; gk8[5] = k1.y; gk8[6] = k1.z; gk8[7] = k1.w; }
    const int hs = ug, col = hs < 4 ? C_DQ + hs * 64 : C_DK + (hs - 4) * 64;
    for (int m0 = F.gw; m0 < T; m0 += 6 * F.NGW) {
        v4u raw[6], kbv[6];
#pragma unroll
        for (int u = 0; u < 6; ++u) { const int m = m0 + u * F.NGW; raw[u] = (v4u){0u, 0u, 0u, 0u}; kbv[u] = raw[u];
            if (m < T) { const bf16* pr = F.PROJ() + (size_t)m * PW; raw[u] = *(const v4u*)(pr + col + 8 * j); if (m < TCTX) kbv[u] = *(const v4u*)(pr + (F.lane < 32 ? C_BK : C_BV) + 8 * (F.lane & 31)); } }
        f32x4 rqa[6][4];
#pragma unroll
        for (int u = 0; u < 6; ++u) { const int m = m0 + u * F.NGW;
#pragma unroll
            for (int i = 0; i < 4; ++i) rqa[u][i] = (f32x4){1.f, 0.f, 1.f, 0.f};
            if (m < T && m >= TCTX) { const int t = (m - TCTX) & 4095, pos = j < 4 ? (t >> 6) : (t & 63); const f32x4* rp = (const f32x4*)(rope + (pos * 16 + ((8 * j) & 15)) * 2);
#pragma unroll
                for (int i = 0; i < 4; ++i) rqa[u][i] = rp[i]; } }
#pragma unroll
        for (int u = 0; u < 6; ++u) { const int m = m0 + u * F.NGW; if (m >= T) continue;
            const bool lat = m >= TCTX; const int t = lat ? ((m - TCTX) & 4095) : (m & 255); const int grow = t >> 6, gcol = t & 63;
            bf16* pr = F.PROJ() + (size_t)m * PW;
            float x[8]; x[0] = bflo(raw[u].x); x[1] = bfhi(raw[u].x); x[2] = bflo(raw[u].y); x[3] = bfhi(raw[u].y); x[4] = bflo(raw[u].z); x[5] = bfhi(raw[u].z); x[6] = bflo(raw[u].w); x[7] = bfhi(raw[u].w);
            float ss = 0.f;
#pragma unroll
            for (int i = 0; i < 8; ++i) ss += x[i] * x[i];
            ss += shx<1>(ss); ss += shx<2>(ss); ss += shx<4>(ss);
            const float rn = rsqrtf(ss * (1.f / 64.f) + EPS) * (hs < 4 ? AT_C : 1.f);
            float y[8];
#pragma unroll
            for (int i = 0; i < 8; ++i) y[i] = x[i] * rn * (hs < 4 ? gq8[i] : gk8[i]);
            if (lat) {
                const f32x4 rq[4] = {rqa[u][0], rqa[u][1], rqa[u][2], rqa[u][3]};
#pragma unroll
                for (int i = 0; i < 8; ++i) { const float p = shx<2>(y[i]); const float cs = rq[i >> 1][(i & 1) * 2], sn = rq[i >> 1][(i & 1) * 2 + 1];
                    y[i] = (j & 2) ? y[i] * cs + p * sn : y[i] * cs - p * sn; }
            }
            if (hs < 6) { v4u o; o.x = pk2(y[0], y[1]); o.y = pk2(y[2], y[3]); o.z = pk2(y[4], y[5]); o.w = pk2(y[6], y[7]); if (!F.dry) *(v4u*)(pr + col + 8 * j) = o; }
            if (!lat && !F.dry) { const int b = m >> 8; const size_t r = (size_t)(b * 2 + l) * 256 + t;
                if (hs >= 4) { float* dst = F.out + (hs < 6 ? O_GK : O_GV) + r * 128 + (hs & 1) * 64 + 8 * j;
                    *(f32x4*)dst = hs < 6 ? (f32x4){y[0], y[1], y[2], y[3]} : (f32x4){x[0], x[1], x[2], x[3]}; *(f32x4*)(dst + 4) = hs < 6 ? (f32x4){y[4], y[5], y[6], y[7]} : (f32x4){x[4], x[5], x[6], x[7]}; }
                const v4u kb = kbv[u];
                float* dst = F.out + (F.lane < 32 ? O_NAK : O_NAV) + r * 256 + 8 * (F.lane & 31);
                *(f32x4*)dst = (f32x4){bflo(kb.x), bfhi(kb.x), bflo(kb.y), bfhi(kb.y)}; *(f32x4*)(dst + 4) = (f32x4){bflo(kb.z), bfhi(kb.z), bflo(kb.w), bfhi(kb.w)}; }
        }
    }
#pragma unroll
    for (int kvsel = 0; kvsel < 2; ++kvsel) { const float* cb = inp(F, kvsel ? I_CGV : I_CGK);
        for (int j = F.vcu * NTHR + F.tid; j < 65536; j += F.G * NTHR) { const int b = j >> 13, rem = j & 8191;
            const float* src = cb + (size_t)(b * 2 + l) * (PAST * 128) + rem * 8;
            const f32x4 a = *(const f32x4*)src, c = *(const f32x4*)(src + 4); v4u o; o.x = pk2(a.x, a.y); o.y = pk2(a.z, a.w); o.z = pk2(c.x, c.y); o.w = pk2(c.z, c.w);
            if (!F.dry) *(v4u*)((bf16*)(F.ws + WS_GQC) + ((size_t)b * PAST + (rem >> 4)) * PW + kvsel * 128 + (rem & 15) * 8) = o; } }
}

typedef float f32x16 __attribute__((ext_vector_type(16)));
typedef short s16x4 __attribute__((ext_vector_type(4)));
constexpr int AT_KSTR = 144, AT_VSTR = 144, AT_KBYTES = 64 * AT_KSTR, AT_STG = 18432, AT_BIAS_OFF = 2 * AT_STG;
struct AttnCfg {
    int q_m0, qcol, zcol;
    int nA, kA_m0, kcol, vcol;
    int nB, strideB; const float* kB; const float* vB;
    int na_r, na_R0, na_qc0;
    float sc;
};
template <bool NA, bool BOUND = false>
__device__ __forceinline__ void attn_item(Frame& F, const AttnCfg& c, const float kn2 = 0.f) {
    int tid_ = F.tid; asm volatile("" : "+v"(tid_));
    const int tid = tid_, lane = tid & 63, r = lane & 31, h = lane >> 5;
    LAS unsigned char* lds = F.lds; bf16* P = F.PROJ();
    bf16x8 qf[4];
    { const bf16* qp = P + (size_t)(c.q_m0 + r) * PW + c.qcol + 8 * h;
#pragma unroll
      for (int kk = 0; kk < 4; ++kk) qf[kk] = *(const bf16x8*)(qp + 16 * kk); }
    f32x16 o0, o1;
#pragma unroll
    for (int i = 0; i < 16; ++i) { o0[i] = 0.f; o1[i] = 0.f; }
    float mrow = -3.0e38f, lsum = 0.f;
    if (BOUND) { float q2 = 0.f;
#pragma unroll
        for (int kk = 0; kk < 4; ++kk) { const v4u w = __builtin_bit_cast(v4u, qf[kk]);
            q2 += bflo(w.x) * bflo(w.x) + bfhi(w.x) * bfhi(w.x) + bflo(w.y) * bflo(w.y) + bfhi(w.y) * bfhi(w.y) + bflo(w.z) * bflo(w.z) + bfhi(w.z) * bfhi(w.z) + bflo(w.w) * bflo(w.w) + bfhi(w.w) * bfhi(w.w); }
        q2 = half_sum(q2);
        mrow = sqrtf(q2 * kn2) * (c.sc * 1.02f); }
    const int ntiles = c.nA + c.nB, srow = tid >> 3, sch = tid & 7;
    v4u kA, vA; f32x4 kB0, kB1, vB0, vB1;
    kA = (v4u){0u, 0u, 0u, 0u}; vA = kA; kB0 = (f32x4){0.f, 0.f, 0.f, 0.f}; kB1 = kB0; vB0 = kB0; vB1 = kB0;
#define AT_LOAD(t) do { if ((t) < c.nA) { const bf16* p_ = P + (size_t)(c.kA_m0 + 64 * (t) + srow) * PW + sch * 8; kA = *(const v4u*)(p_ + c.kcol); vA = *(const v4u*)(p_ + c.vcol); } \
        else { const size_t o_ = (size_t)(64 * ((t) - c.nA) + srow) * c.strideB + sch * 8; kB0 = *(const f32x4*)(c.kB + o_); kB1 = *(const f32x4*)(c.kB + o_ + 4); vB0 = *(const f32x4*)(c.vB + o_); vB1 = *(const f32x4*)(c.vB + o_ + 4); } } while (0)
#define AT_WRITE(t) do { LAS unsigned char* b_ = lds + ((t) & 1) * AT_STG; v4u kk_, vv_; \
        if ((t) < c.nA) { kk_ = kA; vv_ = vA; } else { kk_.x = pk2(kB0.x, kB0.y); kk_.y = pk2(kB0.z, kB0.w); kk_.z = pk2(kB1.x, kB1.y); kk_.w = pk2(kB1.z, kB1.w); \
            vv_.x = pk2(vB0.x, vB0.y); vv_.y = pk2(vB0.z, vB0.w); vv_.z = pk2(vB1.x, vB1.y); vv_.w = pk2(vB1.z, vB1.w); } \
        *(LAS v4u*)(b_ + srow * AT_KSTR + sch * 16) = kk_; \
        *(LAS v4u*)(b_ + AT_KBYTES + srow * AT_VSTR + sch * 16) = vv_; } while (0)
    AT_LOAD(0);
    const int na_sr = NA ? min(max(c.na_r - 4, 0), 56) : 0;
    for (int t = 0; t < ntiles; ++t) {
        AT_WRITE(t);
        __syncthreads();
        if (t + 1 < ntiles) AT_LOAD(t + 1);
        bool active = true; int dr = 0;
        if (NA) { if (t < c.nA) { const int R = c.na_R0 + t; active = (R >= na_sr) && (R <= na_sr + 7); dr = R - c.na_r + 7; } }
        if (active) {
            const LAS unsigned char* Kt = lds + (t & 1) * AT_STG; const LAS unsigned char* Vt = Kt + AT_KBYTES;
            f32x16 s0, s1;
#pragma unroll
            for (int i = 0; i < 16; ++i) { s0[i] = 0.f; s1[i] = 0.f; }
#pragma unroll
            for (int kk = 0; kk < 4; ++kk) {
                const bf16x8 k0 = *(const LAS bf16x8*)(Kt + r * AT_KSTR + (16 * kk + 8 * h) * 2), k1 = *(const LAS bf16x8*)(Kt + (32 + r) * AT_KSTR + (16 * kk + 8 * h) * 2);
                s0 = __builtin_amdgcn_mfma_f32_32x32x16_bf16(k0, qf[kk], s0, 0, 0, 0); s1 = __builtin_amdgcn_mfma_f32_32x32x16_bf16(k1, qf[kk], s1, 0, 0, 0);
            }
            bf16x8 vf0[2][2], vf1[2][2];
#pragma unroll
            for (int sub = 0; sub < 2; ++sub)
#pragma unroll
                for (int st = 0; st < 2; ++st) {
                    const LAS unsigned char* vp = Vt + (32 * sub + 16 * st + 4 * h + ((lane & 15) >> 2)) * AT_VSTR + (16 * ((lane >> 4) & 1) + 4 * (lane & 3)) * 2;
                    const s16x4 a0 = __builtin_amdgcn_ds_read_tr16_b64_v4i16((LAS s16x4*)(vp)), a1 = __builtin_amdgcn_ds_read_tr16_b64_v4i16((LAS s16x4*)(vp + 8 * AT_VSTR));
                    const s16x4 c0 = __builtin_amdgcn_ds_read_tr16_b64_v4i16((LAS s16x4*)(vp + 64)), c1 = __builtin_amdgcn_ds_read_tr16_b64_v4i16((LAS s16x4*)(vp + 64 + 8 * AT_VSTR));
                    vf0[sub][st] = __builtin_shufflevector(a0, a1, 0, 1, 2, 3, 4, 5, 6, 7); vf1[sub][st] = __builtin_shufflevector(c0, c1, 0, 1, 2, 3, 4, 5, 6, 7); }
            __builtin_amdgcn_sched_barrier(0);
            if (NA && t < c.nA) {
                const int qc = c.na_qc0 + r, sc = min(max(qc - 8, 0), 48);
                const LAS float* bt = (const LAS float*)(lds + AT_BIAS_OFF) + dr * 31 + 15 - qc + 4 * h;
                const unsigned kb = (unsigned)(4 * h - sc);
#pragma unroll
                for (int i = 0; i < 16; ++i) { const int k0_ = (i & 3) + 8 * (i >> 2);
                    s0[i] = (kb + (unsigned)k0_ < 16u) ? __builtin_fmaf(s0[i], c.sc, bt[k0_]) : -1.0e30f;
                    s1[i] = (kb + (unsigned)(32 + k0_) < 16u) ? __builtin_fmaf(s1[i], c.sc, bt[32 + k0_]) : -1.0e30f; }
            }
            const float sc_ = (NA && t < c.nA) ? 1.f : c.sc;
            float mn = mrow;
            if (!BOUND) {
                float mxa = fmaxf(s0[0], s0[1]), mxb = fmaxf(s1[0], s1[1]);
#pragma unroll
                for (int i = 2; i < 16; i += 2) { mxa = fmaxf(mxa, fmaxf(s0[i], s0[i + 1])); mxb = fmaxf(mxb, fmaxf(s1[i], s1[i + 1])); }
                float mx = fmaxf(mxa, mxb) * sc_;
                mx = half_max(mx);
                mn = fmaxf(mrow, mx);
                const float alpha = __builtin_amdgcn_exp2f(mrow - mn); mrow = mn; lsum *= alpha;
#pragma unroll
                for (int i = 0; i < 16; ++i) { o0[i] *= alpha; o1[i] *= alpha; }
            }
            if (BOUND) {
                f32x2 ps2 = {0.f, 0.f}; const f32x2 sc2 = {sc_, sc_}, mn2 = {mn, mn};
#pragma unroll
                for (int i = 0; i < 16; i += 2) {
                    f32x2 a = {s0[i], s0[i + 1]}, b = {s1[i], s1[i + 1]}; a = a * sc2 - mn2; b = b * sc2 - mn2;
                    a.x = __builtin_amdgcn_exp2f(a.x); a.y = __builtin_amdgcn_exp2f(a.y); b.x = __builtin_amdgcn_exp2f(b.x); b.y = __builtin_amdgcn_exp2f(b.y);
                    s0[i] = a.x; s0[i + 1] = a.y; s1[i] = b.x; s1[i + 1] = b.y; ps2 += a + b; }
                lsum += ps2.x + ps2.y;
            } else {
                float psa = 0.f, psb = 0.f;
#pragma unroll
                for (int i = 0; i < 16; ++i) { s0[i] = __builtin_amdgcn_exp2f(__builtin_fmaf(s0[i], sc_, -mn)); s1[i] = __builtin_amdgcn_exp2f(__builtin_fmaf(s1[i], sc_, -mn)); psa += s0[i]; psb += s1[i]; }
                lsum += psa + psb;
            }
            bf16x8 pf[2][2];
#pragma unroll
            for (int st = 0; st < 2; ++st) { v4u a, b;
                a.x = pk2(s0[8 * st + 0], s0[8 * st + 1]); a.y = pk2(s0[8 * st + 2], s0[8 * st + 3]); a.z = pk2(s0[8 * st + 4], s0[8 * st + 5]); a.w = pk2(s0[8 * st + 6], s0[8 * st + 7]);
                b.x = pk2(s1[8 * st + 0], s1[8 * st + 1]); b.y = pk2(s1[8 * st + 2], s1[8 * st + 3]); b.z = pk2(s1[8 * st + 4], s1[8 * st + 5]); b.w = pk2(s1[8 * st + 6], s1[8 * st + 7]);
                pf[0][st] = __builtin_bit_cast(bf16x8, a); pf[1][st] = __builtin_bit_cast(bf16x8, b); }
#pragma unroll
            for (int sub = 0; sub < 2; ++sub)
#pragma unroll
                for (int st = 0; st < 2; ++st) {
                    const bf16x8 v0 = vf0[sub][st], v1 = vf1[sub][st];
                    o0 = __builtin_amdgcn_mfma_f32_32x32x16_bf16(v0, pf[sub][st], o0, 0, 0, 0); o1 = __builtin_amdgcn_mfma_f32_32x32x16_bf16(v1, pf[sub][st], o1, 0, 0, 0);
                }
        }
    }
#undef AT_LOAD
#undef AT_WRITE
    const float linv = 1.f / half_sum(lsum);
    bf16* orow = P + (size_t)(c.q_m0 + r) * PW;
    v2u zq[4][2];
#pragma unroll
    for (int g = 0; g < 4; ++g)
#pragma unroll
        for (int dt = 0; dt < 2; ++dt) zq[g][dt] = *(const v2u*)(orow + c.zcol + 32 * dt + 8 * g + 4 * h);
#pragma unroll
    for (int g = 0; g < 4; ++g) {
#pragma unroll
        for (int dt = 0; dt < 2; ++dt) { const int d = 32 * dt + 8 * g + 4 * h;
            const v2u zz = zq[g][dt];
            float y0, y1, y2, y3;
            if (dt == 0) { y0 = o0[4 * g]; y1 = o0[4 * g + 1]; y2 = o0[4 * g + 2]; y3 = o0[4 * g + 3]; } else { y0 = o1[4 * g]; y1 = o1[4 * g + 1]; y2 = o1[4 * g + 2]; y3 = o1[4 * g + 3]; }
            v2u w; w.x = pk2(y0 * linv * silu(bflo(zz.x)), y1 * linv * silu(bfhi(zz.x))); w.y = pk2(y2 * linv * silu(bflo(zz.y)), y3 * linv * silu(bfhi(zz.y)));
            if (!F.dry) *(v2u*)(orow + c.qcol + d) = w; }
    }
    __syncthreads();
}

constexpr int GQ_SLOT = 8192, GQ_K = 0, GQ_V = 3 * GQ_SLOT, GQ_WSF = 6 * GQ_SLOT, GQ_OST = GQ_WSF + 8 * 256, GQ_OROW = 68, GQ_OSTW = 32 * GQ_OROW * 4, GQ_NT = 72;
static_assert(GQ_OST + 8 * GQ_OSTW <= RING_BYTES, "gqa unit LDS");
__device__ __forceinline__ int gq_crow(int r, int hi) { return (r & 3) + 8 * (r >> 2) + 4 * hi; }
__device__ __forceinline__ unsigned gq_cvtpk(float lo, float hi) { unsigned r; asm("v_cvt_pk_bf16_f32 %0, %1, %2" : "=v"(r) : "v"(lo), "v"(hi)); return r; }
__device__ __forceinline__ void gq_glds16(const void* g, unsigned lds_base) {
    unsigned sv; asm volatile("s_mov_b32 %0, m0\n\ts_mov_b32 m0, %2\n\ts_nop 0\n\tglobal_load_lds_dwordx4 %1, off\n\ts_mov_b32 m0, %0" : "=&s"(sv) : "v"(g), "s"(lds_base) : "memory"); }
typedef const LAS unsigned char* gq_lptr;
__device__ __forceinline__ void gq_kload2(bf16x8* kf, gq_lptr kp, int d0) { kf[2 * d0] = *(const LAS bf16x8*)(kp + d0 * 2048); kf[2 * d0 + 1] = *(const LAS bf16x8*)(kp + d0 * 2048 + 512); }
__device__ __forceinline__ s16x4 gq_vtr(gq_lptr p) { return __builtin_amdgcn_ds_read_tr16_b64_v4i16((LAS s16x4*)p); }
#define GQ_SBAR() __builtin_amdgcn_sched_barrier(0)
#define GQ_PIN(x) asm volatile("" : "+v"(x))
#define GQ_MFMA(a, b, c) __builtin_amdgcn_mfma_f32_32x32x16_bf16(a, b, c, 0, 0, 0)
#define GQ_WAIT_BAR(N) asm volatile("s_waitcnt vmcnt(" #N ") lgkmcnt(0)\n\ts_barrier" ::: "memory")
__device__ __forceinline__ void gqa_unit(Frame& F, int b, int kv, int qb, const float kn2) {
    int lane_ = F.lane; asm volatile("" : "+v"(lane_));
    const int lane = lane_, r32 = lane & 31, hi = lane >> 5, wid = __builtin_amdgcn_readfirstlane(F.wave_s);
    LAS unsigned char* lds = F.lds; bf16* P = F.PROJ();
    const int mb = TCTX + b * LAT_L, hd = kv * 2 + (wid >> 2), q_m0 = mb + qb * 128 + (wid & 3) * 32, qcol = C_DQ + hd * 64, zcol = C_DZ + hd * 64;
    const unsigned lds0 = (unsigned)(size_t)lds;
    const char* baseA = (const char*)(P + (size_t)mb * PW + C_DK + kv * 64);
    const char* baseB = (const char*)((const bf16*)(F.ws + WS_GQC) + (size_t)b * PAST * PW + kv * 64);
    const int vrow = 16 * (wid & 3) + (lane >> 2), vc = (wid >> 2) * 32 + (lane & 3) * 8;
    const unsigned kvoA = (unsigned)(lane * PW + wid * 8) * 2u, vvoA = (unsigned)(vrow * PW + vc + (C_DV - C_DK)) * 2u;
    const unsigned kdst = (unsigned)__builtin_amdgcn_readfirstlane(lds0 + GQ_K + wid * 1024), vdst = (unsigned)__builtin_amdgcn_readfirstlane(lds0 + GQ_V + wid * 1024);
#define GQ_TB(t) (((t) < 64 ? baseA : baseB - (size_t)64 * (64 * PW * 2)) + (size_t)(t) * (64 * PW * 2))
#define GQ_DMA_K(t, slot) gq_glds16(GQ_TB(t) + kvoA, (unsigned)__builtin_amdgcn_readfirstlane(kdst + (slot)))
#define GQ_DMA_V(t, slot) gq_glds16(GQ_TB(t) + vvoA, (unsigned)__builtin_amdgcn_readfirstlane(vdst + (slot)))
    const gq_lptr vp0 = (gq_lptr)lds + GQ_V + ((lane >> 4) & 1) * 32 + (lane & 3) * 8 + (4 * hi + ((lane & 15) >> 2)) * 64;
    const gq_lptr kp0 = (gq_lptr)lds + GQ_K + hi * 1024 + r32 * 16;
    LAS float* wsf = (LAS float*)(lds + GQ_WSF) + wid * 64;
    GQ_DMA_K(0, 0); GQ_DMA_V(0, 0); GQ_DMA_K(1, GQ_SLOT);
    bf16x8 qr[4];
    { const bf16* qp = P + (size_t)(q_m0 + r32) * PW + qcol + 8 * hi;
#pragma unroll
      for (int d0 = 0; d0 < 4; ++d0) qr[d0] = *(const bf16x8*)(qp + 16 * d0); }
    GQ_DMA_K(2, 2 * GQ_SLOT);
    float q2 = 0.f;
#pragma unroll
    for (int d0 = 0; d0 < 4; ++d0) { const v4u w = __builtin_bit_cast(v4u, qr[d0]);
        q2 += bflo(w.x) * bflo(w.x) + bfhi(w.x) * bfhi(w.x) + bflo(w.y) * bflo(w.y) + bfhi(w.y) * bfhi(w.y) + bflo(w.z) * bflo(w.z) + bfhi(w.z) * bfhi(w.z) + bflo(w.w) * bflo(w.w) + bfhi(w.w) * bfhi(w.w); }
    q2 = half_sum(q2);
    const float nmb = -sqrtf(q2 * kn2) * 1.02f;
    f32x16 nmb16;
#pragma unroll
    for (int i = 0; i < 16; ++i) nmb16[i] = nmb;
    GQ_PIN(nmb16);
    float l_reg = 0.f; f32x16 o[2];
#pragma unroll
    for (int i = 0; i < 16; ++i) { o[0][i] = 0.f; o[1][i] = 0.f; }
    f32x16 pA0, pA1, pB0, pB1; bf16x8 kf[8]; s16x4 vlo[8], vhi[8]; v4u pw0, pw1, pw2, pw3;
    int sl_prev = 0, sl_cur = 0, sl_next = GQ_SLOT;
#define GQ_ROT() do { sl_prev = sl_cur; sl_cur = sl_next; sl_next = (sl_next == 2 * GQ_SLOT) ? 0 : sl_next + GQ_SLOT; } while (0)
    GQ_WAIT_BAR(3);
#pragma unroll
    for (int d0 = 0; d0 < 4; ++d0) gq_kload2(kf, kp0, d0);
    pA0 = GQ_MFMA(kf[0], qr[0], nmb16); pA1 = GQ_MFMA(kf[1], qr[0], nmb16); pA0 = GQ_MFMA(kf[2], qr[1], pA0); pA1 = GQ_MFMA(kf[3], qr[1], pA1);
    pA0 = GQ_MFMA(kf[4], qr[2], pA0); pA1 = GQ_MFMA(kf[5], qr[2], pA1); pA0 = GQ_MFMA(kf[6], qr[3], pA0); pA1 = GQ_MFMA(kf[7], qr[3], pA1);
#pragma unroll
    for (int r = 0; r < 16; ++r) { pA0[r] = __builtin_amdgcn_exp2f(pA0[r]); pA1[r] = __builtin_amdgcn_exp2f(pA1[r]); }
    GQ_WAIT_BAR(0);
    GQ_DMA_K(3, 0); GQ_DMA_V(1, GQ_SLOT); GQ_ROT();
#pragma unroll
    for (int d0 = 0; d0 < 4; ++d0) gq_kload2(kf, kp0 + sl_cur, d0);
    GQ_WAIT_BAR(2);
#define GQ_PKW(Pv, i) gq_cvtpk(Pv[i], Pv[i + 1])
#define GQ_PAF(k) __builtin_bit_cast(bf16x8, pw##k)
#define GQ_VFR(i) (bf16x8){vlo[i][0], vlo[i][1], vlo[i][2], vlo[i][3], vhi[i][0], vhi[i][1], vhi[i][2], vhi[i][3]}
#define GQ_VRD(i) do { vlo[i] = gq_vtr(vp_ + (((i) >> 2) * 4096 + ((i) & 3) * 1024)); vhi[i] = gq_vtr(vp_ + (((i) >> 2) * 4096 + ((i) & 3) * 1024 + 512)); } while (0)
#define GQ_KRD(G, d0) do { if (G) { gq_kload2(kf, kp0 + sl_next, d0); GQ_SBAR(); } } while (0)
#define GQ_GAPA(MF, a0, a1, a2, a3, W0, W1, PWV) do { MF; sacc += a0; sacc += a1; sacc += a2; sacc += a3; W0; W1; GQ_PIN(PWV); GQ_PIN(sacc); GQ_SBAR(); } while (0)
#define GQ_GAPB(MF, X, i) do { MF; X[i] = __builtin_amdgcn_exp2f(X[i]); X[i + 1] = __builtin_amdgcn_exp2f(X[i + 1]); X[i + 2] = __builtin_amdgcn_exp2f(X[i + 2]); X[i + 3] = __builtin_amdgcn_exp2f(X[i + 3]); GQ_PIN(X); GQ_SBAR(); } while (0)
#define GQ_STEP(C0, C1, P0, P1, t, GK, GV, GL) do { GQ_SBAR(); \
    const gq_lptr vp_ = vp0 + sl_prev; \
    GQ_VRD(0); GQ_SBAR(); float sacc = P0[0] + P0[1]; \
                       GQ_GAPA(C0 = GQ_MFMA(kf[0], qr[0], nmb16), P0[2], P0[3], P0[4], P0[5],     pw0[0] = GQ_PKW(P0, 0),  pw0[1] = GQ_PKW(P0, 2),  pw0); \
    GQ_VRD(4); GQ_SBAR(); GQ_GAPA(C1 = GQ_MFMA(kf[1], qr[0], nmb16), P0[6], P0[7], P0[8], P0[9],     pw0[2] = GQ_PKW(P0, 4),  pw0[3] = GQ_PKW(P0, 6),  pw0); \
    GQ_VRD(1); GQ_SBAR(); GQ_GAPA(C0 = GQ_MFMA(kf[2], qr[1], C0),    P0[10], P0[11], P0[12], P0[13], pw1[0] = GQ_PKW(P0, 8),  pw1[1] = GQ_PKW(P0, 10), pw1); \
    GQ_VRD(5); GQ_SBAR(); GQ_GAPA(C1 = GQ_MFMA(kf[3], qr[1], C1),    P0[14], P0[15], P1[0], P1[1],   pw1[2] = GQ_PKW(P0, 12), pw1[3] = GQ_PKW(P0, 14), pw1); \
    GQ_VRD(2); GQ_SBAR(); GQ_GAPA(C0 = GQ_MFMA(kf[4], qr[2], C0),    P1[2], P1[3], P1[4], P1[5],     pw2[0] = GQ_PKW(P1, 0),  pw2[1] = GQ_PKW(P1, 2),  pw2); \
    GQ_VRD(6); GQ_SBAR(); GQ_GAPA(C1 = GQ_MFMA(kf[5], qr[2], C1),    P1[6], P1[7], P1[8], P1[9],     pw2[2] = GQ_PKW(P1, 4),  pw2[3] = GQ_PKW(P1, 6),  pw2); \
    GQ_VRD(3); GQ_SBAR(); GQ_GAPA(C0 = GQ_MFMA(kf[6], qr[3], C0),    P1[10], P1[11], P1[12], P1[13], pw3[0] = GQ_PKW(P1, 8),  pw3[1] = GQ_PKW(P1, 10), pw3); \
    GQ_VRD(7); GQ_SBAR(); GQ_GAPA(C1 = GQ_MFMA(kf[7], qr[3], C1),    P1[14], P1[15], 0.f, 0.f,       pw3[2] = GQ_PKW(P1, 12), pw3[3] = GQ_PKW(P1, 14), pw3); \
    l_reg += sacc; \
    if (GK) GQ_DMA_K((t) + 3, sl_cur); if (GV) GQ_DMA_V((t) + 1, sl_next); \
    GQ_SBAR(); \
    GQ_GAPB(o[0] = GQ_MFMA(GQ_PAF(0), GQ_VFR(0), o[0]), C0, 0);                 GQ_GAPB(o[1] = GQ_MFMA(GQ_PAF(0), GQ_VFR(4), o[1]), C0, 4); \
    GQ_KRD(GL, 0); GQ_GAPB(o[0] = GQ_MFMA(GQ_PAF(1), GQ_VFR(1), o[0]), C0, 8);  GQ_KRD(GL, 1); GQ_GAPB(o[1] = GQ_MFMA(GQ_PAF(1), GQ_VFR(5), o[1]), C0, 12); \
    GQ_KRD(GL, 2); GQ_GAPB(o[0] = GQ_MFMA(GQ_PAF(2), GQ_VFR(2), o[0]), C1, 0);  GQ_KRD(GL, 3); GQ_GAPB(o[1] = GQ_MFMA(GQ_PAF(2), GQ_VFR(6), o[1]), C1, 4); \
    GQ_GAPB(o[0] = GQ_MFMA(GQ_PAF(3), GQ_VFR(3), o[0]), C1, 8);                 GQ_GAPB(o[1] = GQ_MFMA(GQ_PAF(3), GQ_VFR(7), o[1]), C1, 12); \
    } while (0)
    int t = 1;
    for (; t + 5 < GQ_NT; t += 2) {
        GQ_STEP(pB0, pB1, pA0, pA1, t, true, true, true);     GQ_WAIT_BAR(2); GQ_ROT();
        GQ_STEP(pA0, pA1, pB0, pB1, t + 1, true, true, true); GQ_WAIT_BAR(2); GQ_ROT();
    }
#define GQ_ENDW(tt) do { if ((tt) + 3 < GQ_NT) { GQ_WAIT_BAR(2); } else if ((tt) + 2 < GQ_NT) { GQ_WAIT_BAR(1); } else { GQ_WAIT_BAR(0); } } while (0)
    for (; t + 1 < GQ_NT; t += 2) {
        GQ_STEP(pB0, pB1, pA0, pA1, t, (t + 3 < GQ_NT), (t + 1 < GQ_NT), (t + 1 < GQ_NT));         GQ_ENDW(t);     GQ_ROT();
        GQ_STEP(pA0, pA1, pB0, pB1, t + 1, (t + 4 < GQ_NT), (t + 2 < GQ_NT), (t + 2 < GQ_NT));     GQ_ENDW(t + 1); GQ_ROT();
    }
    GQ_STEP(pB0, pB1, pA0, pA1, GQ_NT - 1, false, false, false);
    v4u zq[4];
#pragma unroll
    for (int i = 0; i < 4; ++i) zq[i] = *(const v4u*)(P + (size_t)(q_m0 + i * 8 + (lane >> 3)) * PW + zcol + (lane & 7) * 8);
    { float sacc = pB0[0] + pB0[1];
#pragma unroll
      for (int r = 2; r < 16; ++r) sacc += pB0[r];
#pragma unroll
      for (int r = 0; r < 16; ++r) sacc += pB1[r];
      l_reg += sacc;
      pw0 = (v4u){GQ_PKW(pB0, 0), GQ_PKW(pB0, 2), GQ_PKW(pB0, 4), GQ_PKW(pB0, 6)}; pw1 = (v4u){GQ_PKW(pB0, 8), GQ_PKW(pB0, 10), GQ_PKW(pB0, 12), GQ_PKW(pB0, 14)};
      pw2 = (v4u){GQ_PKW(pB1, 0), GQ_PKW(pB1, 2), GQ_PKW(pB1, 4), GQ_PKW(pB1, 6)}; pw3 = (v4u){GQ_PKW(pB1, 8), GQ_PKW(pB1, 10), GQ_PKW(pB1, 12), GQ_PKW(pB1, 14)};
      const gq_lptr vp_ = vp0 + sl_cur;
#pragma unroll
      for (int i = 0; i < 8; ++i) GQ_VRD(i);
      o[0] = GQ_MFMA(GQ_PAF(0), GQ_VFR(0), o[0]); o[1] = GQ_MFMA(GQ_PAF(0), GQ_VFR(4), o[1]); o[0] = GQ_MFMA(GQ_PAF(1), GQ_VFR(1), o[0]); o[1] = GQ_MFMA(GQ_PAF(1), GQ_VFR(5), o[1]);
      o[0] = GQ_MFMA(GQ_PAF(2), GQ_VFR(2), o[0]); o[1] = GQ_MFMA(GQ_PAF(2), GQ_VFR(6), o[1]); o[0] = GQ_MFMA(GQ_PAF(3), GQ_VFR(3), o[0]); o[1] = GQ_MFMA(GQ_PAF(3), GQ_VFR(7), o[1]); }
    l_reg = half_sum(l_reg);
    if (hi == 0) wsf[r32] = l_reg;
    LDS_WAIT();
    LAS float* stg = (LAS float*)(lds + GQ_OST + wid * GQ_OSTW);
    float rl[16];
#pragma unroll
    for (int r = 0; r < 16; ++r) rl[r] = wsf[gq_crow(r, hi)];
#pragma unroll
    for (int r = 0; r < 16; ++r) { const int orow = gq_crow(r, hi); const float rli = __builtin_amdgcn_rcpf(rl[r]);
        stg[orow * GQ_OROW + r32] = o[0][r] * rli; stg[orow * GQ_OROW + 32 + r32] = o[1][r] * rli; }
    LDS_WAIT();
#pragma unroll
    for (int i = 0; i < 4; ++i) { const int row = i * 8 + (lane >> 3), ch = lane & 7;
        const f32x4 a = *(const LAS f32x4*)(stg + row * GQ_OROW + ch * 8), c = *(const LAS f32x4*)(stg + row * GQ_OROW + ch * 8 + 4);
        bf16* orow = P + (size_t)(q_m0 + row) * PW; const v4u zz = zq[i]; v4u w;
        w.x = pk2(a.x * silu(bflo(zz.x)), a.y * silu(bfhi(zz.x))); w.y = pk2(a.z * silu(bflo(zz.y)), a.w * silu(bfhi(zz.y)));
        w.z = pk2(c.x * silu(bflo(zz.z)), c.y * silu(bfhi(zz.z))); w.w = pk2(c.z * silu(bflo(zz.w)), c.w * silu(bfhi(zz.w)));
        if (!F.dry) *(v4u*)(orow + qcol + ch * 8) = w; }
    asm volatile("s_waitcnt lgkmcnt(0)\n\ts_barrier" ::: "memory");
#undef GQ_TB
#undef GQ_DMA_K
#undef GQ_DMA_V
#undef GQ_ROT
#undef GQ_PKW
#undef GQ_PAF
#undef GQ_VFR
#undef GQ_VRD
#undef GQ_KRD
#undef GQ_GAPA
#undef GQ_GAPB
#undef GQ_STEP
#undef GQ_ENDW
}

constexpr int NA_BIAS = GQ_OST + 8 * GQ_OSTW;
constexpr float NA_THR = 8.f;
static_assert(NA_BIAS + 465 * 4 <= RING_BYTES, "na unit LDS");
__device__ __forceinline__ float na_rowmax(const f32x16& p0, const f32x16& p1) {
    float a = fmaxf(fmaxf(p0[0], p0[1]), p1[0]), b = fmaxf(fmaxf(p0[2], p0[3]), p1[1]); a = fmaxf(fmaxf(a, p1[2]), p1[3]);
#pragma unroll
    for (int r = 4; r < 16; r += 4) { a = fmaxf(fmaxf(a, p0[r]), p0[r + 1]); b = fmaxf(fmaxf(b, p0[r + 2]), p0[r + 3]); a = fmaxf(fmaxf(a, p1[r]), p1[r + 1]); b = fmaxf(fmaxf(b, p1[r + 2]), p1[r + 3]); }
    return half_max(fmaxf(a, b)); }
__device__ __forceinline__ void na_unit(Frame& F, int l, int it) {
    int lane_ = F.lane; asm volatile("" : "+v"(lane_));
    const int lane = lane_, r32 = lane & 31, hi = lane >> 5, wid = __builtin_amdgcn_readfirstlane(F.wave_s);
    LAS unsigned char* lds = F.lds; bf16* P = F.PROJ();
    const int b = it >> 6, hd = (it >> 4) & 3, rg = it & 15, r0 = rg * 4, mb = TCTX + b * LAT_L;
    const int R0 = min(max(r0 - 4, 0), 56), R1 = min(max(r0 + 3 - 4, 0), 56) + 7, nA = R1 - R0 + 1, NT = 8 + nA + ((8 + nA) & 1);
    const int na_r = r0 + (wid >> 1), qc0 = (wid & 1) * 32, q_m0 = mb + na_r * 64 + qc0, qcol = C_BQ + hd * 64, zcol = C_BZ + hd * 64;
    const int sr = min(max(na_r - 4, 0), 56), qc = qc0 + r32, sc = min(max(qc - 8, 0), 48);
    { const float* rb = inp(F, I_NABIAS) + (size_t)(l * 4 + hd) * 465; LAS float* bt = (LAS float*)(lds + NA_BIAS); const int ti = (wid << 6) | lane; if (ti < 465) bt[ti] = rb[ti] * 1.44269504088896f; }
    const unsigned lds0 = (unsigned)(size_t)lds;
    const char* baseA = (const char*)(P + (size_t)(mb + R0 * 64) * PW + C_BK + hd * 64);
    const char* baseB = (const char*)((const bf16*)(F.ws + WS_NAC) + (size_t)(l * 8 + b) * PAST * PW + hd * 64);
    const int vrow = 16 * (wid & 3) + (lane >> 2), vc = (wid >> 2) * 32 + (lane & 3) * 8;
    const unsigned kvoA = (unsigned)(lane * PW + wid * 8) * 2u, vvoA = (unsigned)(vrow * PW + vc + (C_BV - C_BK)) * 2u;
    const unsigned kdst = (unsigned)__builtin_amdgcn_readfirstlane(lds0 + GQ_K + wid * 1024), vdst = (unsigned)__builtin_amdgcn_readfirstlane(lds0 + GQ_V + wid * 1024);
#define NA_TB(t) ((t) < 8 ? baseB + (size_t)(t) * (64 * PW * 2) : baseA + (size_t)min((t) - 8, nA - 1) * (64 * PW * 2))
#define NA_DMA_K(t, slot) gq_glds16(NA_TB(t) + kvoA, (unsigned)__builtin_amdgcn_readfirstlane(kdst + (slot)))
#define NA_DMA_V(t, slot) gq_glds16(NA_TB(t) + vvoA, (unsigned)__builtin_amdgcn_readfirstlane(vdst + (slot)))
    const gq_lptr vp0 = (gq_lptr)lds + GQ_V + ((lane >> 4) & 1) * 32 + (lane & 3) * 8 + (4 * hi + ((lane & 15) >> 2)) * 64;
    const gq_lptr kp0 = (gq_lptr)lds + GQ_K + hi * 1024 + r32 * 16;
    LAS float* wsf = (LAS float*)(lds + GQ_WSF) + wid * 64;
    NA_DMA_K(0, 0); NA_DMA_V(0, 0); NA_DMA_K(1, GQ_SLOT);
    bf16x8 qr[4];
    { const bf16* qp = P + (size_t)(q_m0 + r32) * PW + qcol + 8 * hi;
#pragma unroll
      for (int d0 = 0; d0 < 4; ++d0) qr[d0] = *(const bf16x8*)(qp + 16 * d0); }
    NA_DMA_K(2, 2 * GQ_SLOT);
    float mhat = 0.f, l_reg = 0.f; f32x16 o[2];
#pragma unroll
    for (int i = 0; i < 16; ++i) { o[0][i] = 0.f; o[1][i] = 0.f; }
    bool resc = false;
    f32x16 pA0, pA1, pB0, pB1, nmb16; bf16x8 kf[8]; s16x4 vlo[8], vhi[8]; v4u pw0, pw1, pw2, pw3;
    int sl_prev = 0, sl_cur = 0, sl_next = GQ_SLOT;
#define NA_ROT() do { sl_prev = sl_cur; sl_cur = sl_next; sl_next = (sl_next == 2 * GQ_SLOT) ? 0 : sl_next + GQ_SLOT; } while (0)
#define NA_RESC() do { if (resc) { _Pragma("unroll") for (int r_ = 0; r_ < 16; ++r_) { const float f_ = wsf[gq_crow(r_, hi)]; o[0][r_] *= f_; o[1][r_] *= f_; } } } while (0)
    GQ_WAIT_BAR(3);
#pragma unroll
    for (int d0 = 0; d0 < 4; ++d0) gq_kload2(kf, kp0, d0);
    { f32x16 z16;
#pragma unroll
      for (int i = 0; i < 16; ++i) z16[i] = 0.f;
      pA0 = GQ_MFMA(kf[0], qr[0], z16); pA1 = GQ_MFMA(kf[1], qr[0], z16); }
    pA0 = GQ_MFMA(kf[2], qr[1], pA0); pA1 = GQ_MFMA(kf[3], qr[1], pA1);
    pA0 = GQ_MFMA(kf[4], qr[2], pA0); pA1 = GQ_MFMA(kf[5], qr[2], pA1); pA0 = GQ_MFMA(kf[6], qr[3], pA0); pA1 = GQ_MFMA(kf[7], qr[3], pA1);
    mhat = na_rowmax(pA0, pA1);
#pragma unroll
    for (int r = 0; r < 16; ++r) { pA0[r] = __builtin_amdgcn_exp2f(pA0[r] - mhat); pA1[r] = __builtin_amdgcn_exp2f(pA1[r] - mhat); }
#pragma unroll
    for (int i = 0; i < 16; ++i) nmb16[i] = -mhat;
    GQ_PIN(nmb16);
    GQ_WAIT_BAR(0);
    NA_DMA_K(3, 0); NA_DMA_V(1, GQ_SLOT); NA_ROT();
#pragma unroll
    for (int d0 = 0; d0 < 4; ++d0) gq_kload2(kf, kp0 + sl_cur, d0);
    GQ_WAIT_BAR(2);
#define NA_PKW(Pv, i) gq_cvtpk(Pv[i], Pv[i + 1])
#define NA_PAF(k) __builtin_bit_cast(bf16x8, pw##k)
#define NA_VFR(i) (bf16x8){vlo[i][0], vlo[i][1], vlo[i][2], vlo[i][3], vhi[i][0], vhi[i][1], vhi[i][2], vhi[i][3]}
#define NA_VRD(i) do { vlo[i] = gq_vtr(vp_ + (((i) >> 2) * 4096 + ((i) & 3) * 1024)); vhi[i] = gq_vtr(vp_ + (((i) >> 2) * 4096 + ((i) & 3) * 1024 + 512)); } while (0)
#define NA_KRD(G, d0) do { if (G) { gq_kload2(kf, kp0 + sl_next, d0); GQ_SBAR(); } } while (0)
#define NA_GAPA(MF, a0, a1, a2, a3, W0, W1, PWV) do { MF; sacc += a0; sacc += a1; sacc += a2; sacc += a3; W0; W1; GQ_PIN(PWV); GQ_PIN(sacc); GQ_SBAR(); } while (0)
#define NA_GAPB(MF, X, i) do { MF; X[i] = __builtin_amdgcn_exp2f(X[i]); X[i + 1] = __builtin_amdgcn_exp2f(X[i + 1]); X[i + 2] = __builtin_amdgcn_exp2f(X[i + 2]); X[i + 3] = __builtin_amdgcn_exp2f(X[i + 3]); GQ_PIN(X); GQ_SBAR(); } while (0)
#define NA_HOOK(C0, C1, t) do { const int w_ = (t) - 8, R_ = R0 + w_; \
        if (w_ < nA && R_ >= sr && R_ <= sr + 7) { \
            const LAS float* bt_ = (const LAS float*)(lds + NA_BIAS) + (R_ - na_r + 7) * 31 + 15 - qc + 4 * hi; const unsigned kb_ = (unsigned)(4 * hi - sc); \
              \
            float b_[16]; \
            _Pragma("unroll") for (int i_ = 0; i_ < 16; ++i_) b_[i_] = bt_[(i_ & 3) + 8 * (i_ >> 2)]; \
            _Pragma("unroll") for (int i_ = 0; i_ < 16; ++i_) asm volatile("" : "+v"(b_[i_])); \
            _Pragma("unroll") for (int i_ = 0; i_ < 16; ++i_) { const float a_ = C0[i_] + b_[i_]; C0[i_] = (kb_ + (unsigned)((i_ & 3) + 8 * (i_ >> 2)) < 16u) ? a_ : -1.0e30f; } \
            _Pragma("unroll") for (int i_ = 0; i_ < 16; ++i_) b_[i_] = bt_[32 + (i_ & 3) + 8 * (i_ >> 2)]; \
            _Pragma("unroll") for (int i_ = 0; i_ < 16; ++i_) asm volatile("" : "+v"(b_[i_])); \
            _Pragma("unroll") for (int i_ = 0; i_ < 16; ++i_) { const float a_ = C1[i_] + b_[i_]; C1[i_] = (kb_ + (unsigned)(32 + (i_ & 3) + 8 * (i_ >> 2)) < 16u) ? a_ : -1.0e30f; } \
        } else { _Pragma("unroll") for (int i_ = 0; i_ < 16; ++i_) { C0[i_] = -1.0e30f; C1[i_] = -1.0e30f; } } } while (0)
#define NA_STEP(C0, C1, P0, P1, t, GK, GV, GL) do { GQ_SBAR(); \
    const gq_lptr vp_ = vp0 + sl_prev; \
    NA_VRD(0); GQ_SBAR(); float sacc = P0[0] + P0[1]; \
                          NA_GAPA(C0 = GQ_MFMA(kf[0], qr[0], nmb16), P0[2], P0[3], P0[4], P0[5],     pw0[0] = NA_PKW(P0, 0),  pw0[1] = NA_PKW(P0, 2),  pw0); \
    NA_VRD(4); GQ_SBAR(); NA_GAPA(C1 = GQ_MFMA(kf[1], qr[0], nmb16), P0[6], P0[7], P0[8], P0[9],     pw0[2] = NA_PKW(P0, 4),  pw0[3] = NA_PKW(P0, 6),  pw0); \
    NA_VRD(1); GQ_SBAR(); NA_GAPA(C0 = GQ_MFMA(kf[2], qr[1], C0),    P0[10], P0[11], P0[12], P0[13], pw1[0] = NA_PKW(P0, 8),  pw1[1] = NA_PKW(P0, 10), pw1); \
    NA_VRD(5); GQ_SBAR(); NA_GAPA(C1 = GQ_MFMA(kf[3], qr[1], C1),    P0[14], P0[15], P1[0], P1[1],   pw1[2] = NA_PKW(P0, 12), pw1[3] = NA_PKW(P0, 14), pw1); \
    NA_VRD(2); GQ_SBAR(); NA_GAPA(C0 = GQ_MFMA(kf[4], qr[2], C0),    P1[2], P1[3], P1[4], P1[5],     pw2[0] = NA_PKW(P1, 0),  pw2[1] = NA_PKW(P1, 2),  pw2); \
    NA_VRD(6); GQ_SBAR(); NA_GAPA(C1 = GQ_MFMA(kf[5], qr[2], C1),    P1[6], P1[7], P1[8], P1[9],     pw2[2] = NA_PKW(P1, 4),  pw2[3] = NA_PKW(P1, 6),  pw2); \
    NA_VRD(3); GQ_SBAR(); NA_GAPA(C0 = GQ_MFMA(kf[6], qr[3], C0),    P1[10], P1[11], P1[12], P1[13], pw3[0] = NA_PKW(P1, 8),  pw3[1] = NA_PKW(P1, 10), pw3); \
    NA_VRD(7); GQ_SBAR(); NA_GAPA(C1 = GQ_MFMA(kf[7], qr[3], C1),    P1[14], P1[15], 0.f, 0.f,       pw3[2] = NA_PKW(P1, 12), pw3[3] = NA_PKW(P1, 14), pw3); \
    l_reg += sacc; \
    if (GK) NA_DMA_K((t) + 3, sl_cur); if (GV) NA_DMA_V((t) + 1, sl_next); \
    if ((t) >= 8) NA_HOOK(C0, C1, t); \
    { const float rm = na_rowmax(C0, C1); resc = false;                                             \
      if (__builtin_expect(__any(rm > NA_THR), 0)) { const float dl = fmaxf(rm, 0.f); mhat += dl;     \
          const float f = __builtin_amdgcn_exp2f(-dl); l_reg *= f; if (hi == 0) wsf[r32] = f; resc = true; \
          _Pragma("unroll") for (int i_ = 0; i_ < 16; ++i_) { C0[i_] -= dl; C1[i_] -= dl; nmb16[i_] = -mhat; } GQ_PIN(nmb16); } } \
    GQ_SBAR(); \
    NA_GAPB(o[0] = GQ_MFMA(NA_PAF(0), NA_VFR(0), o[0]), C0, 0);                 NA_GAPB(o[1] = GQ_MFMA(NA_PAF(0), NA_VFR(4), o[1]), C0, 4); \
    NA_KRD(GL, 0); NA_GAPB(o[0] = GQ_MFMA(NA_PAF(1), NA_VFR(1), o[0]), C0, 8);  NA_KRD(GL, 1); NA_GAPB(o[1] = GQ_MFMA(NA_PAF(1), NA_VFR(5), o[1]), C0, 12); \
    NA_KRD(GL, 2); NA_GAPB(o[0] = GQ_MFMA(NA_PAF(2), NA_VFR(2), o[0]), C1, 0);  NA_KRD(GL, 3); NA_GAPB(o[1] = GQ_MFMA(NA_PAF(2), NA_VFR(6), o[1]), C1, 4); \
    NA_GAPB(o[0] = GQ_MFMA(NA_PAF(3), NA_VFR(3), o[0]), C1, 8);                 NA_GAPB(o[1] = GQ_MFMA(NA_PAF(3), NA_VFR(7), o[1]), C1, 12); \
    } while (0)
#define NA_ENDW(tt) do { if ((tt) + 3 < NT) { GQ_WAIT_BAR(2); } else if ((tt) + 2 < NT) { GQ_WAIT_BAR(1); } else { GQ_WAIT_BAR(0); } } while (0)
    int t = 1;
    for (; t + 5 < NT; t += 2) {
        NA_STEP(pB0, pB1, pA0, pA1, t, true, true, true);     GQ_WAIT_BAR(2); NA_RESC(); NA_ROT();
        NA_STEP(pA0, pA1, pB0, pB1, t + 1, true, true, true); GQ_WAIT_BAR(2); NA_RESC(); NA_ROT();
    }
    for (; t + 1 < NT; t += 2) {
        NA_STEP(pB0, pB1, pA0, pA1, t, (t + 3 < NT), (t + 1 < NT), (t + 1 < NT));         NA_ENDW(t);     NA_RESC(); NA_ROT();
        NA_STEP(pA0, pA1, pB0, pB1, t + 1, (t + 4 < NT), (t + 2 < NT), (t + 2 < NT));     NA_ENDW(t + 1); NA_RESC(); NA_ROT();
    }
    NA_STEP(pB0, pB1, pA0, pA1, NT - 1, false, false, false); NA_RESC();
    v4u zq[4];
#pragma unroll
    for (int i = 0; i < 4; ++i) zq[i] = *(const v4u*)(P + (size_t)(q_m0 + i * 8 + (lane >> 3)) * PW + zcol + (lane & 7) * 8);
    { float sacc = pB0[0] + pB0[1];
#pragma unroll
      for (int r = 2; r < 16; ++r) sacc += pB0[r];
#pragma unroll
      for (int r = 0; r < 16; ++r) sacc += pB1[r];
      l_reg += sacc;
      pw0 = (v4u){NA_PKW(pB0, 0), NA_PKW(pB0, 2), NA_PKW(pB0, 4), NA_PKW(pB0, 6)}; pw1 = (v4u){NA_PKW(pB0, 8), NA_PKW(pB0, 10), NA_PKW(pB0, 12), NA_PKW(pB0, 14)};
      pw2 = (v4u){NA_PKW(pB1, 0), NA_PKW(pB1, 2), NA_PKW(pB1, 4), NA_PKW(pB1, 6)}; pw3 = (v4u){NA_PKW(pB1, 8), NA_PKW(pB1, 10), NA_PKW(pB1, 12), NA_PKW(pB1, 14)};
      const gq_lptr vp_ = vp0 + sl_cur;
#pragma unroll
      for (int i = 0; i < 8; ++i) NA_VRD(i);
      o[0] = GQ_MFMA(NA_PAF(0), NA_VFR(0), o[0]); o[1] = GQ_MFMA(NA_PAF(0), NA_VFR(4), o[1]); o[0] = GQ_MFMA(NA_PAF(1), NA_VFR(1), o[0]); o[1] = GQ_MFMA(NA_PAF(1), NA_VFR(5), o[1]);
      o[0] = GQ_MFMA(NA_PAF(2), NA_VFR(2), o[0]); o[1] = GQ_MFMA(NA_PAF(2), NA_VFR(6), o[1]); o[0] = GQ_MFMA(NA_PAF(3), NA_VFR(3), o[0]); o[1] = GQ_MFMA(NA_PAF(3), NA_VFR(7), o[1]); }
    l_reg = half_sum(l_reg);
    LDS_WAIT();
    if (hi == 0) wsf[r32] = l_reg;
    LDS_WAIT();
    LAS float* stg = (LAS float*)(lds + GQ_OST + wid * GQ_OSTW);
    float rl[16];
#pragma unroll
    for (int r = 0; r < 16; ++r) rl[r] = wsf[gq_crow(r, hi)];
#pragma unroll
    for (int r = 0; r < 16; ++r) { const int orow = gq_crow(r, hi); const float rli = __builtin_amdgcn_rcpf(rl[r]);
        stg[orow * GQ_OROW + r32] = o[0][r] * rli; stg[orow * GQ_OROW + 32 + r32] = o[1][r] * rli; }
    LDS_WAIT();
#pragma unroll
    for (int i = 0; i < 4; ++i) { const int row = i * 8 + (lane >> 3), ch = lane & 7;
        const f32x4 a = *(const LAS f32x4*)(stg + row * GQ_OROW + ch * 8), c = *(const LAS f32x4*)(stg + row * GQ_OROW + ch * 8 + 4);
        bf16* orow = P + (size_t)(q_m0 + row) * PW; const v4u zz = zq[i]; v4u w;
        w.x = pk2(a.x * silu(bflo(zz.x)), a.y * silu(bfhi(zz.x))); w.y = pk2(a.z * silu(bflo(zz.y)), a.w * silu(bfhi(zz.y)));
        w.z = pk2(c.x * silu(bflo(zz.z)), c.y * silu(bfhi(zz.z))); w.w = pk2(c.z * silu(bflo(zz.w)), c.w * silu(bfhi(zz.w)));
        if (!F.dry) *(v4u*)(orow + qcol + ch * 8) = w; }
    asm volatile("s_waitcnt lgkmcnt(0)\n\ts_barrier" ::: "memory");
#undef NA_TB
#undef NA_DMA_K
#undef NA_DMA_V
#undef NA_ROT
#undef NA_RESC
#undef NA_PKW
#undef NA_PAF
#undef NA_VFR
#undef NA_VRD
#undef NA_KRD
#undef NA_GAPA
#undef NA_GAPB
#undef NA_HOOK
#undef NA_STEP
#undef NA_ENDW
}
__device__ __forceinline__ void at_ctxB(Frame& F, int it) { const int b = it >> 2, hd = it & 3; AttnCfg c{};
    c.q_m0 = b * 256 + F.wave * 32; c.qcol = C_BQ + hd * 64; c.zcol = C_BZ + hd * 64; c.nA = 4; c.kA_m0 = b * 256; c.kcol = C_BK + hd * 64; c.vcol = C_BV + hd * 64; c.nB = 0; c.strideB = 0; c.kB = nullptr; c.vB = nullptr; c.sc = 1.f;
    attn_item<false>(F, c); }
__device__ __forceinline__ void at_ctxD(Frame& F, int l, int it) { const int b = it >> 2, kv = (it >> 1) & 1, qb = it & 1, hd = kv * 2 + (F.wave >> 2); AttnCfg c{};
    c.q_m0 = b * 256 + qb * 128 + (F.wave & 3) * 32; c.qcol = C_DQ + hd * 64; c.zcol = C_DZ + hd * 64; c.nA = 4; c.kA_m0 = b * 256; c.kcol = C_DK + kv * 64; c.vcol = C_DV + kv * 64; c.nB = 0; c.strideB = 0; c.kB = nullptr; c.vB = nullptr; c.sc = 1.f;
    const float gk = fabsf(inp(F, I_GKG)[l * 64 + F.lane]); float gm = gk;
    gm = wave_max(gm);
    float gq = fabsf(inp(F, I_GQG)[l * 64 + F.lane]);
    gq = wave_max(gq);
    if (8.f * gq * gm < 40.f) attn_item<false, true>(F, c, 64.f * gm * gm); else attn_item<false>(F, c); }
__device__ __forceinline__ void at_gqa(Frame& F, int l, int it) { const int b = it >> 6, kv = (it >> 5) & 1, qb = it & 31, hd = kv * 2 + (F.wave >> 2), mb = TCTX + b * LAT_L; AttnCfg c{};
    c.q_m0 = mb + qb * 128 + (F.wave & 3) * 32; c.qcol = C_DQ + hd * 64; c.zcol = C_DZ + hd * 64; c.nA = 64; c.kA_m0 = mb; c.kcol = C_DK + kv * 64; c.vcol = C_DV + kv * 64;
    c.nB = 8; c.strideB = 128; const size_t o = ((size_t)(b * 2 + l) * PAST * 2 + kv) * 64; c.kB = inp(F, I_CGK) + o; c.vB = inp(F, I_CGV) + o; c.sc = 1.f;
    const float gk = fabsf(inp(F, I_GKG)[l * 64 + F.lane]); float gm = gk;
    gm = wave_max(gm);
    const float kn2 = fmaxf(64.f * gm * gm, ((const float*)(F.ws + WS_KNC))[(l * 8 + b) * 2 + kv]);
    float gq = fabsf(inp(F, I_GQG)[l * 64 + F.lane]);
    gq = wave_max(gq);
    if (sqrtf(64.f * gq * gq * kn2) * 0.125f < 40.f) gqa_unit(F, b, kv, qb, kn2); else attn_item<false>(F, c); }
__device__ __forceinline__ void at_na(Frame& F, int l, int it) { const int b = it >> 6, hd = (it >> 4) & 3, rg = it & 15, r0 = rg * 4, mb = TCTX + b * LAT_L; AttnCfg c{};
    const int R0 = min(max(r0 - 4, 0), 56), R1 = min(max(r0 + 3 - 4, 0), 56) + 7;
    { const float* rb = inp(F, I_NABIAS) + (size_t)(l * 4 + hd) * 465; LAS float* bt = (LAS float*)(F.lds + AT_BIAS_OFF); for (int i = F.tid; i < 465; i += NTHR) bt[i] = rb[i] * 1.44269504088896f; }
    c.na_r = r0 + (F.wave >> 1); c.na_R0 = R0; c.na_qc0 = (F.wave & 1) * 32;
    c.q_m0 = mb + c.na_r * 64 + c.na_qc0; c.qcol = C_BQ + hd * 64; c.zcol = C_BZ + hd * 64; c.nA = R1 - R0 + 1; c.kA_m0 = mb + R0 * 64; c.kcol = C_BK + hd * 64; c.vcol = C_BV + hd * 64;
    c.nB = 8; c.strideB = 256; const size_t o = ((size_t)(b * 2 + l) * PAST * 4 + hd) * 64; c.kB = inp(F, I_CNAK) + o; c.vB = inp(F, I_CNAV) + o; c.sc = 1.f;
    attn_item<true>(F, c); }
__device__ __forceinline__ void ph_attn1(Frame& F, int l) {
    relocal(F);
    __syncthreads();
    for (int it = F.vcu; it < 512; it += F.G) na_unit(F, l, it);
    if (F.G < 128) for (int it = F.G - 1 - F.vcu; it < 64; it += F.G) at_ctxB(F, it);
}
__device__ __forceinline__ void ph_gmlp(Frame& F, int l, int part = 0);
__device__ __forceinline__ void ph_attn2(Frame& F, int l) {
    relocal(F);
    __syncthreads();
    for (int it = F.vcu; it < 512; it += F.G) at_gqa(F, l, it);
    for (int it = F.G - 1 - F.vcu; it < 64; it += F.G) at_ctxD(F, l, it);
    ph_gmlp(F, l, 1);
    if (F.G >= 128) { const int it = F.G - 65 - F.vcu; if (it >= 0 && it < 64) at_ctxB(F, it); }
}


constexpr size_t S5_KC = WS_S5T, S5_WIN = WS_S5T + 1 * MiB, S5_WOUT = WS_S5T + 3 * MiB, S5_L8 = WS_S5T + 5 * MiB;
constexpr int NCHUNK = T / 8;
__device__ __forceinline__ void s5_build_tables(Frame& F, int it4) {
    const int it = it4 >> 2, qq = it4 & 3, l = it >> 4, g = it & 15;
    LAS float* pw = (LAS float*)F.lds;
    LAS float* bb = pw + 2 * 64 * 9 * 2;
    LAS float* cc = bb + 2 * 64 * 16 * 2;
    if (F.tid < 128) { const int d = F.tid >> 6, p = F.tid & 63, ldg = (l * 2 + d) * 16 + g;
        const float dt = expf(inp(F, I_LOGDT)[ldg]); const float are = inp(F, I_ARE)[ldg * 64 + p], aim = inp(F, I_AIM)[ldg * 64 + p];
        float lr = 1.f, li = 0.f;
        for (int e = 0; e <= 8; ++e) { const float mg = expf((float)e * dt * are); float sn, cs; sincosf((float)e * dt * aim, &sn, &cs); pw[((d * 64 + p) * 9 + e) * 2] = mg * cs; pw[((d * 64 + p) * 9 + e) * 2 + 1] = mg * sn; if (e == 1) { lr = mg * cs; li = mg * sn; } }
        const float den = are * are + aim * aim, nr = lr - 1.f, ni = li; const float cr = (nr * are + ni * aim) / den, ci = (ni * are - nr * aim) / den;
        const float* pbr = inp(F, I_BRE) + ((size_t)ldg * 64 + p) * 16; const float* pbi = inp(F, I_BIM) + ((size_t)ldg * 64 + p) * 16;
        const float* pcr = inp(F, I_CRE) + (size_t)ldg * 16 * 64 + p; const float* pci = inp(F, I_CIM) + (size_t)ldg * 16 * 64 + p;
        f32x4 brv[4], biv[4]; float crv[16], civ[16];
#pragma unroll
        for (int j = 0; j < 4; ++j) { brv[j] = *(const f32x4*)(pbr + 4 * j); biv[j] = *(const f32x4*)(pbi + 4 * j); }
#pragma unroll
        for (int j = 0; j < 16; ++j) { crv[j] = pcr[j * 64]; civ[j] = pci[j * 64]; }
#pragma unroll
        for (int j = 0; j < 16; ++j) { const float br = brv[j >> 2][j & 3], bi = biv[j >> 2][j & 3];
            bb[((d * 64 + p) * 16 + j) * 2] = cr * br - ci * bi; bb[((d * 64 + p) * 16 + j) * 2 + 1] = cr * bi + ci * br;
            cc[((d * 16 + j) * 64 + p) * 2] = crv[j]; cc[((d * 16 + j) * 64 + p) * 2 + 1] = civ[j]; }
        float* l8 = (float*)(F.ws + S5_L8) + ((size_t)ldg * 64 + p) * 2; l8[0] = pw[((d * 64 + p) * 9 + 8) * 2]; l8[1] = pw[((d * 64 + p) * 9 + 8) * 2 + 1];
    }
    __syncthreads();
    { bf16* kc = (bf16*)(F.ws + S5_KC) + (size_t)it * 15 * 256; const float* sd = inp(F, I_SSMD) + l * 256 + g * 16;
      for (int idx = qq * 1024 + F.tid; idx < min(15 * 256, qq * 1024 + 1024); idx += NTHR) { const int ti = idx >> 8, i = (idx >> 4) & 15, j = idx & 15, tau = ti - 7; float s = 0.f;
          for (int d = 0; d < 2; ++d) { if ((d == 0 && tau < 0) || (d == 1 && tau > 0)) continue; const int e = tau < 0 ? -tau : tau;
              for (int p = 0; p < 64; ++p) { const float cr = cc[((d * 16 + i) * 64 + p) * 2], ci = cc[((d * 16 + i) * 64 + p) * 2 + 1], wr_ = pw[((d * 64 + p) * 9 + e) * 2], wi = pw[((d * 64 + p) * 9 + e) * 2 + 1];
                  const float br = bb[((d * 64 + p) * 16 + j) * 2], bi = bb[((d * 64 + p) * 16 + j) * 2 + 1];
                  const float xr = cr * wr_ - ci * wi, xi = cr * wi + ci * wr_; s += xr * br - xi * bi; } }
          if (tau == 0 && i == j) s += sd[i];
          kc[idx] = (bf16)f2bf(s); } }
    { const int d = qq >> 1; const int ldg = (l * 2 + d) * 16 + g;
        bf16* win = (bf16*)(F.ws + S5_WIN) + (size_t)ldg * 16384; bf16* wout = (bf16*)(F.ws + S5_WOUT) + (size_t)ldg * 16384;
        for (int idx = (qq & 1) * 8192 + F.tid; idx < (qq & 1) * 8192 + 8192; idx += NTHR) {
            { const int a = idx >> 11, i = (idx >> 7) & 15, p = (idx >> 1) & 63, c = idx & 1, e = d == 0 ? a + 1 : 8 - a;
              const float cr = cc[((d * 16 + i) * 64 + p) * 2], ci = cc[((d * 16 + i) * 64 + p) * 2 + 1], wr_ = pw[((d * 64 + p) * 9 + e) * 2], wi = pw[((d * 64 + p) * 9 + e) * 2 + 1];
              win[idx] = (bf16)f2bf(c == 0 ? cr * wr_ - ci * wi : -(cr * wi + ci * wr_)); }
            { const int p = idx >> 8, c = (idx >> 7) & 1, b = (idx >> 4) & 7, j = idx & 15, e = d == 0 ? 7 - b : b;
              const float wr_ = pw[((d * 64 + p) * 9 + e) * 2], wi = pw[((d * 64 + p) * 9 + e) * 2 + 1], br = bb[((d * 64 + p) * 16 + j) * 2], bi = bb[((d * 64 + p) * 16 + j) * 2 + 1];
              wout[idx] = (bf16)f2bf(c == 0 ? wr_ * br - wi * bi : wr_ * bi + wi * br); }
        } }
    __syncthreads();
}
constexpr int S5_ROW = 272;
__device__ __forceinline__ void ph_s5_s1(Frame& F, int l) {
    relocal(F);
    const int fr = F.lane & 15, q = F.lane >> 4, w = F.wave, dir = w >> 2;
    float* sloc = (float*)(F.ws + WS_XN);
    for (int it = blockIdx.x; it < 256; it += F.G) {
        const int g = it >> 4, cg = it & 15, ldg = (l * 2 + dir) * 16 + g;
        const bf16* wout = (const bf16*)(F.ws + S5_WOUT) + (size_t)ldg * 16384;
        bf16x8 af[2][4];
#pragma unroll
        for (int rt = 0; rt < 2; ++rt)
#pragma unroll
            for (int ks = 0; ks < 4; ++ks) af[rt][ks] = *(const bf16x8*)(wout + (size_t)((w & 3) * 32 + rt * 16 + fr) * 128 + 32 * ks + 8 * q);
        const bf16* cxg = F.CX() + (size_t)g * T * 16;
        v4u pa = (v4u){0u, 0u, 0u, 0u}, pb = pa;
        if (F.tid < 256) { pa = *(const v4u*)(cxg + (size_t)(cg * 18) * 2048 + F.tid * 8); pb = *(const v4u*)(cxg + (size_t)(cg * 18 + 1) * 2048 + F.tid * 8); }
        for (int v = 0; v < 9; ++v) {
            const int ct = cg * 18 + 2 * v; LAS unsigned char* buf = F.lds + (v & 1) * (2 * 4352);
            if (F.tid < 256) { *(LAS v4u*)(buf + (F.tid >> 4) * S5_ROW + (F.tid & 15) * 16) = pa; *(LAS v4u*)(buf + 4352 + (F.tid >> 4) * S5_ROW + (F.tid & 15) * 16) = pb; }
            __syncthreads();
            if (v + 1 < 9 && F.tid < 256) { pa = *(const v4u*)(cxg + (size_t)(ct + 2) * 2048 + F.tid * 8); pb = *(const v4u*)(cxg + (size_t)(ct + 3) * 2048 + F.tid * 8); }
#pragma unroll
            for (int h2 = 0; h2 < 2; ++h2) {
                f32x4 a0 = (f32x4){0.f, 0.f, 0.f, 0.f}, a1 = a0;
#pragma unroll
                for (int ks = 0; ks < 4; ++ks) { const bf16x8 bfr = *(const LAS bf16x8*)(buf + h2 * 4352 + fr * S5_ROW + 64 * ks + 16 * q);
                    a0 = __builtin_amdgcn_mfma_f32_16x16x32_bf16(af[0][ks], bfr, a0, 0, 0, 0); a1 = __builtin_amdgcn_mfma_f32_16x16x32_bf16(af[1][ks], bfr, a1, 0, 0, 0); }
                float* o = sloc + (((size_t)((ct + h2) * 16 + fr) * 2 + dir) * 16 + g) * 128 + (w & 3) * 32 + 4 * q;
                *(f32x4*)o = a0; *(f32x4*)(o + 16) = a1; }
        }
        __syncthreads();
    }
}
__device__ __forceinline__ void ph_s5_scan(Frame& F, int l) {
    relocal(F);
    const float* sloc = (const float*)(F.ws + WS_XN); unsigned* sin = (unsigned*)(F.ws + WS_SIN);
    const int p = F.lane, w = F.wave;
    for (int it = blockIdx.x; it < 256; it += F.G) {
        const int seq = 16 + (it >> 5), d = (it >> 4) & 1, g = it & 15, nb = 512 + (seq - 16) * 512, ldg = (l * 2 + d) * 16 + g;
        const float* l8 = (const float*)(F.ws + S5_L8) + ((size_t)ldg * 64 + p) * 2; const float lr = l8[0], li = l8[1];
        float2 x[64];
#pragma unroll
        for (int k = 0; k < 64; ++k) { const int kk = 64 * w + k, n = nb + (d ? 511 - kk : kk); x[k] = *(const float2*)(sloc + (((size_t)n * 2 + d) * 16 + g) * 128 + 2 * p); }
        float tr = 0.f, ti = 0.f;
#pragma unroll
        for (int k = 0; k < 64; ++k) { const float nr = lr * tr - li * ti + x[k].x, ni = lr * ti + li * tr + x[k].y; tr = nr; ti = ni; }
        LAS float* red = (LAS float*)F.lds;
        __syncthreads();
        red[(w * 64 + p) * 2] = tr; red[(w * 64 + p) * 2 + 1] = ti;
        __syncthreads();
        float ar = lr, ai = li;
#pragma unroll
        for (int q = 0; q < 6; ++q) { const float nr = ar * ar - ai * ai, ni = 2.f * ar * ai; ar = nr; ai = ni; }
        const size_t o = ((((size_t)(seq - 16) * 2 + l) * 2 + d) * 16 + g) * 64 + p; float sr = inp(F, I_SSM0)[o * 2], si = inp(F, I_SSM0)[o * 2 + 1];
        for (int j = 0; j < w; ++j) { const float nr = ar * sr - ai * si + red[(j * 64 + p) * 2], ni = ar * si + ai * sr + red[(j * 64 + p) * 2 + 1]; sr = nr; si = ni; }
        unsigned* so = sin + ((size_t)(d * 16 + g) * NCHUNK) * 64 + p;
#pragma unroll
        for (int k = 0; k < 64; ++k) { const int kk = 64 * w + k, n = nb + (d ? 511 - kk : kk); so[(size_t)n * 64] = pk2(sr, si);
            const float nr = lr * sr - li * si + x[k].x, ni = lr * si + li * sr + x[k].y; sr = nr; si = ni; }
    }
    if (w >= 6) for (int ci = blockIdx.x * 2 + (w - 6); ci < 512; ci += 2 * F.G) {
        const int seq = ci >> 5, d = (ci >> 4) & 1, g = ci & 15, nb = seq * 32, ldg = (l * 2 + d) * 16 + g;
        const float* l8 = (const float*)(F.ws + S5_L8) + ((size_t)ldg * 64 + p) * 2; const float lr = l8[0], li = l8[1];
        float2 x[32];
#pragma unroll
        for (int k = 0; k < 32; ++k) { const int n = nb + (d ? 31 - k : k); x[k] = *(const float2*)(sloc + (((size_t)n * 2 + d) * 16 + g) * 128 + 2 * p); }
        unsigned* so = sin + ((size_t)(d * 16 + g) * NCHUNK) * 64 + p; float sr = 0.f, si = 0.f;
#pragma unroll
        for (int k = 0; k < 32; ++k) { const int n = nb + (d ? 31 - k : k); so[(size_t)n * 64] = pk2(sr, si);
            const float nr = lr * sr - li * si + x[k].x, ni = lr * si + li * sr + x[k].y; sr = nr; si = ni; }
        const size_t o = ((((size_t)seq * 2 + l) * 2 + d) * 16 + g) * 64 + p; F.out[O_SSM + o * 2] = sr; F.out[O_SSM + o * 2 + 1] = si;
    }
}
__device__ __forceinline__ void ph_s5_s3(Frame& F, int l) {
    relocal(F);
    const int fr = F.lane & 15, q = F.lane >> 4, a = F.wave;
    for (int it = blockIdx.x; it < 256; it += F.G) {
        const int g = it >> 4, cg = it & 15, lg = l * 16 + g;
        bf16x8 af[12];
        { const bf16* kc = (const bf16*)(F.ws + S5_KC) + (size_t)lg * 15 * 256;
#pragma unroll
          for (int ks = 0; ks < 4; ++ks) { const int b = 2 * ks + (q >> 1); af[ks] = *(const bf16x8*)(kc + ((a - b + 7) * 16 + fr) * 16 + 8 * (q & 1)); }
#pragma unroll
          for (int d = 0; d < 2; ++d) { const bf16* win = (const bf16*)(F.ws + S5_WIN) + (size_t)((l * 2 + d) * 16 + g) * 16384 + (size_t)(a * 16 + fr) * 128;
#pragma unroll
              for (int ks = 0; ks < 4; ++ks) af[4 + 4 * d + ks] = *(const bf16x8*)(win + 32 * ks + 8 * q); } }
        bf16* cxg = F.CX() + (size_t)g * T * 16;
        const bf16* sf = (const bf16*)(F.ws + WS_SIN) + (size_t)(0 * 16 + g) * NCHUNK * 128; const bf16* sr_ = (const bf16*)(F.ws + WS_SIN) + (size_t)(1 * 16 + g) * NCHUNK * 128;
        v4u pa0, pa1 = (v4u){0u, 0u, 0u, 0u}, pb0, pb1 = (v4u){0u, 0u, 0u, 0u};
#define S3_LOAD(d0, d1, ct) do { const size_t o_ = (size_t)(ct) * 2048 + (F.tid & 255) * 8; d0 = (F.tid < 256) ? *(const v4u*)(cxg + o_) : *(const v4u*)(sf + o_); if (F.tid < 256) d1 = *(const v4u*)(sr_ + o_); } while (0)
        S3_LOAD(pa0, pa1, cg * 18); S3_LOAD(pb0, pb1, cg * 18 + 1);
        for (int v = 0; v < 9; ++v) {
            const int ct = cg * 18 + 2 * v; LAS unsigned char* buf = F.lds + (v & 1) * (6 * 4352);
            { const int e = F.tid & 255, off = (e >> 4) * S5_ROW + (e & 15) * 16;
              *(LAS v4u*)(buf + (F.tid >> 8) * 4352 + off) = pa0; if (F.tid < 256) *(LAS v4u*)(buf + 2 * 4352 + off) = pa1;
              *(LAS v4u*)(buf + 3 * 4352 + (F.tid >> 8) * 4352 + off) = pb0; if (F.tid < 256) *(LAS v4u*)(buf + 5 * 4352 + off) = pb1; }
            __syncthreads();
            if (v + 1 < 9) { S3_LOAD(pa0, pa1, ct + 2); S3_LOAD(pb0, pb1, ct + 3); }
            f32x4 acc = (f32x4){0.f, 0.f, 0.f, 0.f}, acc2 = acc;
#pragma unroll
            for (int ks = 0; ks < 12; ++ks) { const int bo = (ks >> 2) * 4352 + fr * S5_ROW + 64 * (ks & 3) + 16 * q;
                const bf16x8 bfr = *(const LAS bf16x8*)(buf + bo), bfr2 = *(const LAS bf16x8*)(buf + 3 * 4352 + bo);
                acc = __builtin_amdgcn_mfma_f32_16x16x32_bf16(af[ks], bfr, acc, 0, 0, 0); acc2 = __builtin_amdgcn_mfma_f32_16x16x32_bf16(af[ks], bfr2, acc2, 0, 0, 0); }
            v2u o; o.x = pk2(gelu_tanh(acc[0]), gelu_tanh(acc[1])); o.y = pk2(gelu_tanh(acc[2]), gelu_tanh(acc[3]));
            v2u o2; o2.x = pk2(gelu_tanh(acc2[0]), gelu_tanh(acc2[1])); o2.y = pk2(gelu_tanh(acc2[2]), gelu_tanh(acc2[3]));
            if (!F.dry) { *(v2u*)(cxg + ((size_t)(ct * 16 + fr) * 8 + a) * 16 + 4 * q) = o; *(v2u*)(cxg + ((size_t)((ct + 1) * 16 + fr) * 8 + a) * 16 + 4 * q) = o2; }
        }
#undef S3_LOAD
        __syncthreads();
    }
}
__device__ __forceinline__ void ph_glu(Frame& F, int l) {
    relocal(F);
    const int fr = F.lane & 15, q = F.lane >> 4, w = F.wave;
    constexpr int AROW = 528;
    const bf16* wg = (const bf16*)(F.ws + WS_WGLU) + (size_t)l * 65536; const float* bg = inp(F, I_BGLU) + l * 256;
    bf16x8 bfr[2][8];
#pragma unroll
    for (int nt = 0; nt < 2; ++nt)
#pragma unroll
        for (int ks = 0; ks < 8; ++ks) bfr[nt][ks] = *(const bf16x8*)(wg + (size_t)(32 * w + 16 * nt + fr) * 256 + 32 * ks + 8 * q);
    for (int it = blockIdx.x; it < 256; it += F.G) {
        const int m0 = it * 144;
        for (int e = F.tid; e < 144 * 32; e += NTHR) { const int c = e / 144, row = e - c * 144;
            *(LAS v4u*)(F.lds + row * AROW + c * 16) = *(const v4u*)(F.CX() + ((size_t)(c >> 1) * T + m0 + row) * 16 + 8 * (c & 1)); }
        __syncthreads();
        f32x4 acc[9][2]; v2u zq[9][2];
        const f32x4 bq[2] = {*(const f32x4*)(bg + 32 * w + 4 * q), *(const f32x4*)(bg + 32 * w + 16 + 4 * q)};
#pragma unroll
        for (int mt = 0; mt < 9; ++mt) { acc[mt][0] = (f32x4){0.f, 0.f, 0.f, 0.f}; acc[mt][1] = acc[mt][0];
#pragma unroll
            for (int nt = 0; nt < 2; ++nt) zq[mt][nt] = *(const v2u*)(F.PROJ() + (size_t)(m0 + 16 * mt + fr) * PW + C_CZ + 32 * w + 16 * nt + 4 * q); }
#pragma unroll
        for (int mt = 0; mt < 9; ++mt)
#pragma unroll
            for (int ks = 0; ks < 8; ++ks) { const bf16x8 af = *(const LAS bf16x8*)(F.lds + (16 * mt + fr) * AROW + 64 * ks + 16 * q);
                acc[mt][0] = __builtin_amdgcn_mfma_f32_16x16x32_bf16(bfr[0][ks], af, acc[mt][0], 0, 0, 0); acc[mt][1] = __builtin_amdgcn_mfma_f32_16x16x32_bf16(bfr[1][ks], af, acc[mt][1], 0, 0, 0); }
#pragma unroll
        for (int mt = 0; mt < 9; ++mt)
#pragma unroll
            for (int nt = 0; nt < 2; ++nt) { const int row = 16 * mt + fr, c = 32 * w + 16 * nt + 4 * q;
                const v2u yp = *(const LAS v2u*)(F.lds + row * AROW + c * 2); const f32x4 b4 = bq[nt];
                bf16* pz = F.PROJ() + (size_t)(m0 + row) * PW + C_CZ + c; const v2u zz = zq[mt][nt];
                const float y0 = bflo(yp.x), y1 = bfhi(yp.x), y2 = bflo(yp.y), y3 = bfhi(yp.y);
                v2u o; o.x = pk2(y0 * sigm(acc[mt][nt][0] + b4[0]) * silu(bflo(zz.x)), y1 * sigm(acc[mt][nt][1] + b4[1]) * silu(bfhi(zz.x)));
                o.y = pk2(y2 * sigm(acc[mt][nt][2] + b4[2]) * silu(bflo(zz.y)), y3 * sigm(acc[mt][nt][3] + b4[3]) * silu(bfhi(zz.y)));
                if (!F.dry) *(v2u*)pz = o; }
        __syncthreads();
    }
}

__device__ __forceinline__ void ph_gmlp(Frame& F, int l, int part) {
    const bool split = F.G == 256; if (part == 1 && (!split || F.vcu >= 32)) return;
    relocal(F);
    constexpr int VROW = 272;
    const int r = F.lane & 31, h = F.lane >> 5, w = F.wave, g = w >> 1, qh = w & 1;
    LAS unsigned char* VT = F.lds; LAS float* rinv = (LAS float*)(F.lds + 256 * VROW);
    const bf16* wsb = (const bf16*)(F.ws + WS_GMWS) + (size_t)(l * 4 + g) * 16384; const float* gv = inp(F, I_GMVG) + l * 256; const float* gb = inp(F, I_GMB) + (l * 4 + g) * 128;
    bf16* P = F.PROJ();
    bf16x8 wb0[8], wb1[8];
#pragma unroll
    for (int ks = 0; ks < 8; ++ks) { wb0[ks] = *(const bf16x8*)(wsb + (size_t)(qh * 64 + r) * 128 + 16 * ks + 8 * h); wb1[ks] = *(const bf16x8*)(wsb + (size_t)(qh * 64 + 32 + r) * 128 + 16 * ks + 8 * h); }
    const int ch_lo = part == 1 ? 256 + F.vcu : (int)blockIdx.x, ch_hi = part == 1 ? ch_lo + 1 : (split ? 256 : T / 128);
    for (int ch = ch_lo; ch < ch_hi; ch += F.G) {
        const int m0 = ch * 128;
        { v2u xr[16];
#pragma unroll
          for (int i = 0; i < 16; ++i) xr[i] = *(const v2u*)(P + (size_t)(m0 + w * 16 + i) * PW + C_AV + F.lane * 4);
#pragma unroll
          for (int i = 0; i < 16; ++i) { const v2u x = xr[i];
            const float a = bflo(x.x), b = bfhi(x.x), c = bflo(x.y), d = bfhi(x.y); const float s = wave_sum(a * a + b * b + c * c + d * d); if (F.lane == 0) rinv[w * 16 + i] = rsqrtf(s * (1.f / 256.f) + EPS); } }
        __syncthreads();
        { const int p = F.tid & 127, sq = F.tid >> 7; const float ri = rinv[p]; const bf16* src = P + (size_t)(m0 + p) * PW + C_AV + sq * 64;
          v4u xq[8]; f32x4 gq0[8], gq1[8];
#pragma unroll
          for (int i = 0; i < 8; ++i) { xq[i] = *(const v4u*)(src + 8 * i); gq0[i] = *(const f32x4*)(gv + sq * 64 + 8 * i); gq1[i] = *(const f32x4*)(gv + sq * 64 + 8 * i + 4); }
#pragma unroll
          for (int i = 0; i < 8; ++i) { const v4u x = xq[i]; const int c0 = sq * 64 + 8 * i; const f32x4 g0 = gq0[i], g1 = gq1[i];
              LAS unsigned short* dst = (LAS unsigned short*)(VT + c0 * VROW + p * 2);
              dst[0 * (VROW / 2)] = (unsigned short)f2bf(bflo(x.x) * ri * g0[0]); dst[1 * (VROW / 2)] = (unsigned short)f2bf(bfhi(x.x) * ri * g0[1]); dst[2 * (VROW / 2)] = (unsigned short)f2bf(bflo(x.y) * ri * g0[2]); dst[3 * (VROW / 2)] = (unsigned short)f2bf(bfhi(x.y) * ri * g0[3]);
              dst[4 * (VROW / 2)] = (unsigned short)f2bf(bflo(x.z) * ri * g1[0]); dst[5 * (VROW / 2)] = (unsigned short)f2bf(bfhi(x.z) * ri * g1[1]); dst[6 * (VROW / 2)] = (unsigned short)f2bf(bflo(x.w) * ri * g1[2]); dst[7 * (VROW / 2)] = (unsigned short)f2bf(bfhi(x.w) * ri * g1[3]); } }
        __syncthreads();
        f32x16 acc[2][2];
#pragma unroll
        for (int i = 0; i < 16; ++i) { acc[0][0][i] = 0.f; acc[0][1][i] = 0.f; acc[1][0][i] = 0.f; acc[1][1][i] = 0.f; }
#pragma unroll
        for (int ks = 0; ks < 8; ++ks) {
            const bf16x8 a0 = *(const LAS bf16x8*)(VT + (g * 64 + r) * VROW + (16 * ks + 8 * h) * 2), a1 = *(const LAS bf16x8*)(VT + (g * 64 + 32 + r) * VROW + (16 * ks + 8 * h) * 2);
            const bf16x8 b0 = wb0[ks], b1 = wb1[ks];
            acc[0][0] = __builtin_amdgcn_mfma_f32_32x32x16_bf16(a0, b0, acc[0][0], 0, 0, 0); acc[0][1] = __builtin_amdgcn_mfma_f32_32x32x16_bf16(a0, b1, acc[0][1], 0, 0, 0);
            acc[1][0] = __builtin_amdgcn_mfma_f32_32x32x16_bf16(a1, b0, acc[1][0], 0, 0, 0); acc[1][1] = __builtin_amdgcn_mfma_f32_32x32x16_bf16(a1, b1, acc[1][1], 0, 0, 0);
        }
        __syncthreads();
        { LAS float* stg = (LAS float*)(F.lds + w * 8704);
#pragma unroll
          for (int qt = 0; qt < 2; ++qt) { const float bias = gb[qh * 64 + 32 * qt + r];
#pragma unroll
            for (int dt = 0; dt < 2; ++dt)
#pragma unroll
                for (int gq = 0; gq < 4; ++gq) *(LAS f32x4*)(stg + r * 68 + 32 * dt + 8 * gq + 4 * h) = (f32x4){acc[dt][qt][4 * gq] + bias, acc[dt][qt][4 * gq + 1] + bias, acc[dt][qt][4 * gq + 2] + bias, acc[dt][qt][4 * gq + 3] + bias};
            LDS_WAIT();
            v4u uq[4], zq[4];
#pragma unroll
            for (int i = 0; i < 4; ++i) { const int tk = i * 8 + (F.lane >> 3), ch = F.lane & 7; const bf16* pr = P + (size_t)(m0 + qh * 64 + 32 * qt + tk) * PW + g * 64 + ch * 8;
                uq[i] = *(const v4u*)(pr + C_AU); zq[i] = *(const v4u*)(pr + C_AZ); }
#pragma unroll
            for (int i = 0; i < 4; ++i) { const int tk = i * 8 + (F.lane >> 3), ch = F.lane & 7; bf16* pr = P + (size_t)(m0 + qh * 64 + 32 * qt + tk) * PW + g * 64 + ch * 8;
                const f32x4 s0 = *(const LAS f32x4*)(stg + tk * 68 + ch * 8), s1 = *(const LAS f32x4*)(stg + tk * 68 + ch * 8 + 4);
                const v4u uu = uq[i], zz = zq[i]; v4u o;
                o.x = pk2(bflo(uu.x) * s0.x * silu(bflo(zz.x)), bfhi(uu.x) * s0.y * silu(bfhi(zz.x))); o.y = pk2(bflo(uu.y) * s0.z * silu(bflo(zz.y)), bfhi(uu.y) * s0.w * silu(bfhi(zz.y)));
                o.z = pk2(bflo(uu.z) * s1.x * silu(bflo(zz.z)), bfhi(uu.z) * s1.y * silu(bfhi(zz.z))); o.w = pk2(bflo(uu.w) * s1.z * silu(bflo(zz.w)), bfhi(uu.w) * s1.w * silu(bfhi(zz.w)));
                if (!F.dry) *(v4u*)(pr + C_AU) = o; }
            LDS_WAIT(); } }
        __syncthreads();
    }
}

#ifndef DUP_CODE
#define DUP_CODE 0
#endif
constexpr int NPH_LAYER = 8, PH_FINAL = 1 + 2 * NPH_LAYER, NPHASES = PH_FINAL + 1;
__global__ void __launch_bounds__(NTHR, 2) fwd_kernel(Args args) {
    extern __shared__ __attribute__((aligned(16))) unsigned char lds_raw[];
    Frame F;
    F.lds = (LAS unsigned char*)lds_raw;
    F.tid = threadIdx.x; F.lane = F.tid & 63; F.wave = __builtin_amdgcn_readfirstlane(F.tid >> 6); F.wave_s = F.wave;
    F.G = gridDim.x; F.gw = blockIdx.x * NWAVES + F.wave; F.NGW = F.G * NWAVES;
    { const int bx = blockIdx.x; F.vcu = (F.G % 8 == 0) ? (bx % 8) * (F.G / 8) + bx / 8 : bx; }
    F.in = args.in; F.out = args.out; F.ws = args.ws;
    for (int u = F.tid; u < (LDS_BYTES - LDSCTL_OFF) / 4; u += NTHR) ((LAS unsigned*)(F.lds + LDSCTL_OFF))[u] = 0u;
    __syncthreads();
    const int lo = args.ph_lo, hi = args.ph_hi;
    F.dry = 0;
    XcdBarrier bar; bar.bar = (unsigned*)(F.ws + WS_CTL) + CW_BAR; bar.x = 0; bar.st = nullptr;
    if (hi - lo > 1) bar = xcd_barrier_post((unsigned*)(F.ws + WS_CTL) + CW_BAR, (volatile LAS unsigned*)(F.lds + MISC_OFF) + 8);
#define IN(k) (lo <= (k) && (k) < hi)
#define SEAM(k) do { if (IN(k) && IN((k) + 1)) xcd_barrier(bar); } while (0)
#if DUP_CODE
#define DUPRUN(code, stmt) do { if (DUP_CODE == (code) && l == 0 && args.dup_code == (code)) { xcd_barrier(bar); F.dry = args.dry_val; stmt; F.dry = 0; } } while (0)
#else
#define DUPRUN(code, stmt) do { } while (0)
#endif
#define GEMM_IN() do { pg8::Gemm g{F.XN(), (const bf16*)(F.ws + WS_WIN) + (size_t)l * NPROJ * D, T, NPROJ, D, D}; pg8::StaticOrder S; S.init(T, NPROJ, F.G, (int)blockIdx.x); \
            EpiIn E{F.PROJ(), F.CX(), F.GSIG()}; pg8::gemm_phase<EpiIn, pg8::StaticOrder>(F.lds, g, S, E, F.wave_s); } while (0)
#define GEMM_OUT() do { pg8::Gemm g{F.XN(), (const bf16*)(F.ws + WS_WOUT) + (size_t)l * D * D, T, D, D, D}; pg8::StaticOrder S; S.init(T, D, F.G, (int)blockIdx.x, 192); \
            if (l == 0) { EpiOut192<0> E{inp(F, I_XP), inp(F, I_XS), (bf16*)F.out, (bf16*)(F.ws + WS_PROJ), F.MOD()}; pg8::gemm_phase<EpiOut192<0>, pg8::StaticOrder, 3>(F.lds, g, S, E, F.wave_s); } \
            else { EpiOut192<1> E{inp(F, I_XP), inp(F, I_XS), (bf16*)F.out, (bf16*)(F.ws + WS_PROJ), F.MOD() + (size_t)9 * 3072}; pg8::gemm_phase<EpiOut192<1>, pg8::StaticOrder, 3>(F.lds, g, S, E, F.wave_s); } } while (0)
    { const int l = 0; if (IN(0)) { ph_prologue(F); DUPRUN(14, ph_prologue(F)); } } SEAM(0);
    for (int l = 0; l < DEPTH; ++l) {
        const int pb = 1 + l * NPH_LAYER;
        if (IN(pb + 0)) { ph_norm(F, l); DUPRUN(1, ph_norm(F, l)); } SEAM(pb + 0);
        if (IN(pb + 1)) { GEMM_IN(); DUPRUN(2, GEMM_IN()); } SEAM(pb + 1);
        if (IN(pb + 2)) { ph_prep(F, l); ph_s5_s1(F, l); ph_attn1(F, l); ph_gmlp(F, l);
            DUPRUN(3, ph_prep(F, l)); DUPRUN(4, ph_s5_s1(F, l)); DUPRUN(5, ph_attn1(F, l)); DUPRUN(6, ph_gmlp(F, l)); } SEAM(pb + 2);
        if (IN(pb + 3)) { ph_s5_scan(F, l); ph_attn2(F, l); DUPRUN(7, ph_s5_scan(F, l)); DUPRUN(8, ph_attn2(F, l)); } SEAM(pb + 3);
        if (IN(pb + 4)) { ph_s5_s3(F, l); DUPRUN(9, ph_s5_s3(F, l)); } SEAM(pb + 4);
        if (IN(pb + 5)) { ph_glu(F, l); DUPRUN(10, ph_glu(F, l)); } SEAM(pb + 5);
        if (IN(pb + 6)) { ph_merge(F, l); DUPRUN(11, ph_merge(F, l)); } SEAM(pb + 6);
        if (IN(pb + 7)) { GEMM_OUT(); DUPRUN(12, GEMM_OUT()); DUPRUN(15, { for (int i_ = 0; i_ < 9; ++i_) xcd_barrier(bar); }); } SEAM(pb + 7);
    }
    if (IN(PH_FINAL)) { ph_final(F); }
#undef IN
#undef SEAM
}

#ifndef DUP_CODE_DEFINED
#endif
#ifndef N_LAUNCH_MODE
#define N_LAUNCH_MODE 1
#endif
extern "C" void kernel_launch(void* const* d_in, const int* in_sizes, int n_in, void* d_out, int out_size, void* d_ws, size_t ws_size, hipStream_t stream) {
    static int grid = 0;
    if (grid == 0) {
        if (n_in != 32 || out_size != (int)O_END || ws_size < WS_END) { fprintf(stderr, "kernel_launch: unexpected shapes: n_in %d out %d ws %zu (need %zu)\n", n_in, out_size, ws_size, (size_t)WS_END); grid = -1; return; }
        int dev = 0, cus = 0, per_cu = 0;
        if (hipGetDevice(&dev) != hipSuccess || hipDeviceGetAttribute(&cus, hipDeviceAttributeMultiprocessorCount, dev) != hipSuccess) { grid = -1; return; }
        if (hipFuncSetAttribute((const void*)fwd_kernel, hipFuncAttributeMaxDynamicSharedMemorySize, LDS_BYTES) != hipSuccess) { fprintf(stderr, "kernel_launch: hipFuncSetAttribute failed\n"); grid = -1; return; }
        if (hipOccupancyMaxActiveBlocksPerMultiprocessor(&per_cu, (const void*)fwd_kernel, NTHR, LDS_BYTES) != hipSuccess || per_cu < 1) { fprintf(stderr, "kernel_launch: occupancy query says %d blocks per CU\n", per_cu); grid = -1; (void)hipGetLastError(); return; }
        grid = cus;
    }
    if (grid < 0) return;
    if (hipMemsetAsync((char*)d_ws + WS_CTL, 0, CTL_ZERO_BYTES, stream) != hipSuccess) return;
    Args a{};
    for (int i = 0; i < 32; ++i) a.in[i] = (const float*)d_in[i];
    a.out = (float*)d_out; a.ws = (unsigned char*)d_ws; a.dup_code = DUP_CODE; a.dry_val = 1;
    if (N_LAUNCH_MODE == 1) { a.ph_lo = 0; a.ph_hi = NPHASES; hipLaunchKernelGGL(fwd_kernel, dim3(grid), dim3(NTHR), LDS_BYTES, stream, a); }
    else for (int p = 0; p < NPHASES; ++p) { a.ph_lo = p; a.ph_hi = p + 1; hipLaunchKernelGGL(fwd_kernel, dim3(grid), dim3(NTHR), LDS_BYTES, stream, a); }
}
```
